# Optimizing an MI355X kernel written in HIP

```python
import math
import jax, jax.numpy as jnp
from jax import lax
import numpy as np

D_MODEL = 2048
BATCH = 4
SEQ = 4096
DEPTH = 1

HEAD_DIM = 128
N_HEADS = D_MODEL // HEAD_DIM
N_HEADS_A = N_HEADS // 2
N_HEADS_B = N_HEADS - N_HEADS_A
WIDTH_A = N_HEADS_A * HEAD_DIM
WIDTH_B = N_HEADS_B * HEAD_DIM

DIL_CONFIGS = ((128, 1), (512, 4), (2048, 16))
DIL_BLOCK = 128

NSA_KV_GROUPS = 2
NSA_HPG = N_HEADS_B // NSA_KV_GROUPS
KV_WIDTH_B = NSA_KV_GROUPS * HEAD_DIM
CMP_BLOCK = 32
CMP_STRIDE = 16
CMP_HIDDEN = 2 * HEAD_DIM
SEL_BLOCK = 64
SEL_TOP_N = 16
SEL_FORCED_LOCAL = 2
SEL_Q_CHUNK = 64
FORCE_BONUS = 1.0e3
WIN_SIZE = 512
WIN_BLOCK = 128
N_GATES = 3

FFN_HIDDEN = -(-(8 * D_MODEL) // (3 * 256)) * 256
RMS_EPS = 1e-6
NEG_INF = -1e30

COL_SIZES = (WIDTH_A, WIDTH_A, WIDTH_A,
             WIDTH_B,
             KV_WIDTH_B, KV_WIDTH_B,
             KV_WIDTH_B, KV_WIDTH_B,
             KV_WIDTH_B, KV_WIDTH_B,
             N_HEADS_B * N_GATES)
P_IN = sum(COL_SIZES)

kernel_name = "hybrid_dilated_nsa_swiglu_block"


def rmsnorm(x, g):
    xf = x.astype(jnp.float32)
    y = xf * lax.rsqrt(jnp.mean(xf * xf, axis=-1, keepdims=True) + RMS_EPS)
    return (y * g.astype(jnp.float32)).astype(x.dtype)


def alibi_slopes(n):
    return jnp.exp2(-8.0 * jnp.arange(1, n + 1, dtype=jnp.float32) / n)


def masked_softmax_f32(s, mask):
    s = jnp.where(mask, s, NEG_INF)
    m = jnp.max(s, axis=-1, keepdims=True)
    e = jnp.where(mask, jnp.exp(s - m), 0.0)
    return e / jnp.maximum(jnp.sum(e, axis=-1, keepdims=True), 1e-30)


def split_heads(a, n):
    b, s, _ = a.shape
    return a.reshape(b, s, n, HEAD_DIM).transpose(0, 2, 1, 3)


def dilated_attention_config(q, k, v, slopes, window, dilation):
    B, H, S, hd = q.shape
    L = S // dilation
    nb = -(-L // DIL_BLOCK)
    Lp = nb * DIL_BLOCK
    W = window // dilation
    n_prev = -(-W // DIL_BLOCK)
    scale = 1.0 / math.sqrt(hd)

    def to_sub(a):
        a = a.reshape(B, H, L, dilation, hd).transpose(0, 1, 3, 2, 4)
        a = jnp.pad(a, ((0, 0), (0, 0), (0, 0), (0, Lp - L), (0, 0)))
        return a.reshape(B, H, dilation, nb, DIL_BLOCK, hd)

    def band(a):
        a = jnp.pad(a, ((0, 0), (0, 0), (0, 0), (n_prev, 0), (0, 0), (0, 0)))
        return jnp.concatenate([a[:, :, :, i:i + nb] for i in range(n_prev + 1)], axis=4)

    qs = to_sub(q)
    kb, vb = band(to_sub(k)), band(to_sub(v))
    qi = jnp.arange(nb)[:, None] * DIL_BLOCK + jnp.arange(DIL_BLOCK)[None, :]
    kj = (jnp.arange(nb)[:, None] - n_prev) * DIL_BLOCK + jnp.arange((n_prev + 1) * DIL_BLOCK)[None, :]
    rel = qi[:, :, None] - kj[:, None, :]
    mask = (rel >= 0) & (rel <= W) & (kj[:, None, :] >= 0)
    s = jnp.einsum('bhrnqd,bhrnkd->bhrnqk', qs, kb).astype(jnp.float32) * scale
    s = s - slopes[:, None, None, None, None] * (rel * dilation).astype(jnp.float32)
    s = jnp.where(mask, s, NEG_INF)
    lse = jax.nn.logsumexp(s, axis=-1)
    p = jnp.exp(s - lse[..., None])
    o = jnp.einsum('bhrnqk,bhrnkd->bhrnqd', p.astype(v.dtype), vb)
    o = o.reshape(B, H, dilation, Lp, hd)[:, :, :, :L].transpose(0, 1, 3, 2, 4).reshape(B, H, S, hd)
    lse = lse.reshape(B, H, dilation, Lp)[:, :, :, :L].transpose(0, 1, 3, 2).reshape(B, H, S)
    return o, lse


def dilated_mixture(q, k, v, slopes):
    outs, lses = [], []
    for window, dilation in DIL_CONFIGS:
        o, l = dilated_attention_config(q, k, v, slopes, window, dilation)
        outs.append(o)
        lses.append(l)
    w = jax.nn.softmax(jnp.stack(lses, axis=0), axis=0)
    out = sum(w[i][..., None].astype(q.dtype) * outs[i] for i in range(len(outs)))
    return out


def compress_blocks(kv, pe, w1, w2):
    B, G, S, hd = kv.shape
    nc = S // CMP_STRIDE
    r = CMP_BLOCK // CMP_STRIDE
    n_cmp = nc - r + 1
    chunks = kv.reshape(B, G, nc, CMP_STRIDE, hd)
    blocks = jnp.concatenate([chunks[:, :, i:i + n_cmp] for i in range(r)], axis=3)
    blocks = blocks + pe
    flat = blocks.reshape(B, G, n_cmp, CMP_BLOCK * hd)
    return jax.nn.silu(flat @ w1) @ w2


def nsa_compressed(q, kc, vc, slopes):
    S = q.shape[3]
    n_cmp = kc.shape[2]
    scale = 1.0 / math.sqrt(q.shape[-1])
    t = jnp.arange(S)
    end = jnp.arange(n_cmp) * CMP_STRIDE + CMP_BLOCK - 1
    rel = t[:, None] - end[None, :]
    s = jnp.einsum('bghtd,bgcd->bghtc', q, kc).astype(jnp.float32) * scale
    s = s - slopes[:, :, None, None] * rel.astype(jnp.float32)
    p = masked_softmax_f32(s, rel >= 0)
    o = jnp.einsum('bghtc,bgcd->bghtd', p.astype(vc.dtype), vc)
    return o, p


def nsa_selected(q, k, v, p_cmp, slopes):
    B, G, Hq, S, hd = q.shape
    n_cmp = p_cmp.shape[-1]
    n_sel = S // SEL_BLOCK
    top_n = min(SEL_TOP_N, n_sel)
    scale = 1.0 / math.sqrt(hd)
    cstart = jnp.arange(n_cmp)[:, None] * CMP_STRIDE
    sstart = jnp.arange(n_sel)[None, :] * SEL_BLOCK
    overlap = ((cstart < sstart + SEL_BLOCK) & (cstart + CMP_BLOCK > sstart)).astype(jnp.float32)
    imp = jnp.einsum('bghtc,cn->bgtn', p_cmp, overlap)
    t = jnp.arange(S)
    blk = jnp.arange(n_sel)[None, :]
    cur = (t // SEL_BLOCK)[:, None]
    valid = blk <= cur
    forced = (blk == 0) | ((blk <= cur) & (blk > cur - SEL_FORCED_LOCAL))
    score = jnp.where(valid, imp + jnp.where(forced, FORCE_BONUS, 0.0), -1.0)
    top_s, top_i = lax.top_k(score, top_n)
    sel_ok = top_s >= 0.0

    nq = S // SEL_Q_CHUNK
    qc = q.reshape(B, G, Hq, nq, SEL_Q_CHUNK, hd).transpose(3, 0, 1, 2, 4, 5)
    ic = top_i.reshape(B, G, nq, SEL_Q_CHUNK, top_n).transpose(2, 0, 1, 3, 4)
    oc = sel_ok.reshape(B, G, nq, SEL_Q_CHUNK, top_n).transpose(2, 0, 1, 3, 4)
    tc = t.reshape(nq, SEL_Q_CHUNK)
    kblocks = k.reshape(B, G, n_sel, SEL_BLOCK, hd)
    vblocks = v.reshape(B, G, n_sel, SEL_BLOCK, hd)
    bi = jnp.arange(B)[:, None, None, None]
    gi = jnp.arange(G)[None, :, None, None]
    offs = jnp.arange(SEL_BLOCK)

    def one_chunk(args):
        q_, i_, ok_, t_ = args
        kg = kblocks[bi, gi, i_]
        vg = vblocks[bi, gi, i_]
        pos = i_[..., None] * SEL_BLOCK + offs
        rel = t_[None, None, :, None, None] - pos
        mask = ok_[..., None] & (rel >= 0)
        s = jnp.einsum('bghqd,bgqnkd->bghqnk', q_, kg).astype(jnp.float32) * scale
        s = s - slopes[:, :, None, None, None] * rel[:, :, None].astype(jnp.float32)
        s = jnp.where(mask[:, :, None], s, NEG_INF)
        s = s.reshape(B, G, Hq, SEL_Q_CHUNK, top_n * SEL_BLOCK)
        p = jax.nn.softmax(s, axis=-1)
        return jnp.einsum('bghqm,bgqmd->bghqd', p.astype(v.dtype),
                          vg.reshape(B, G, SEL_Q_CHUNK, top_n * SEL_BLOCK, hd))

    o = lax.map(one_chunk, (qc, ic, oc, tc))
    return o.transpose(1, 2, 3, 0, 4, 5).reshape(B, G, Hq, S, hd)


def nsa_window(q, k, v, slopes):
    B, G, Hq, S, hd = q.shape
    nb = S // WIN_BLOCK
    n_prev = -(-(WIN_SIZE - 1) // WIN_BLOCK)
    scale = 1.0 / math.sqrt(hd)
    qb = q.reshape(B, G, Hq, nb, WIN_BLOCK, hd)

    def band(a):
        a = a.reshape(B, G, nb, WIN_BLOCK, hd)
        a = jnp.pad(a, ((0, 0), (0, 0), (n_prev, 0), (0, 0), (0, 0)))
        return jnp.concatenate([a[:, :, i:i + nb] for i in range(n_prev + 1)], axis=3)

    kb, vb = band(k), band(v)
    qi = jnp.arange(nb)[:, None] * WIN_BLOCK + jnp.arange(WIN_BLOCK)[None, :]
    kj = (jnp.arange(nb)[:, None] - n_prev) * WIN_BLOCK + jnp.arange((n_prev + 1) * WIN_BLOCK)[None, :]
    rel = qi[:, :, None] - kj[:, None, :]
    mask = (rel >= 0) & (rel < WIN_SIZE) & (kj[:, None, :] >= 0)
    s = jnp.einsum('bghnqd,bgnkd->bghnqk', qb, kb).astype(jnp.float32) * scale
    s = s - slopes[:, :, None, None, None] * rel.astype(jnp.float32)
    p = masked_softmax_f32(s, mask)
    o = jnp.einsum('bghnqk,bgnkd->bghnqd', p.astype(v.dtype), vb)
    return o.reshape(B, G, Hq, S, hd)


def setup_inputs(seed: int = 0) -> dict:
    key = jax.random.key(seed)
    ks = jax.random.split(key, 20)
    f32 = jnp.float32
    nrm = lambda k, shape, fan_in: jax.random.normal(k, shape, f32) * (fan_in ** -0.5)
    gain = lambda k, shape: 1.0 + 0.02 * jax.random.normal(k, shape, f32)
    return {
        "x": jax.random.normal(ks[0], (BATCH, SEQ, D_MODEL), f32),
        "norm1_g": gain(ks[1], (DEPTH, D_MODEL)),
        "w_in": nrm(ks[2], (DEPTH, D_MODEL, P_IN), D_MODEL),
        "cmp_pe_k": 0.1 * jax.random.normal(ks[3], (DEPTH, CMP_BLOCK, HEAD_DIM), f32),
        "cmp_w1_k": nrm(ks[4], (DEPTH, CMP_BLOCK * HEAD_DIM, CMP_HIDDEN), CMP_BLOCK * HEAD_DIM),
        "cmp_w2_k": nrm(ks[5], (DEPTH, CMP_HIDDEN, HEAD_DIM), CMP_HIDDEN),
        "cmp_pe_v": 0.1 * jax.random.normal(ks[6], (DEPTH, CMP_BLOCK, HEAD_DIM), f32),
        "cmp_w1_v": nrm(ks[7], (DEPTH, CMP_BLOCK * HEAD_DIM, CMP_HIDDEN), CMP_BLOCK * HEAD_DIM),
        "cmp_w2_v": nrm(ks[8], (DEPTH, CMP_HIDDEN, HEAD_DIM), CMP_HIDDEN),
        "grp_norm_a": gain(ks[9], (DEPTH, WIDTH_A)),
        "grp_norm_b": gain(ks[10], (DEPTH, WIDTH_B)),
        "w_out": nrm(ks[11], (DEPTH, WIDTH_A + WIDTH_B, D_MODEL), WIDTH_A + WIDTH_B),
        "norm2_g": gain(ks[12], (DEPTH, D_MODEL)),
        "w_gate": nrm(ks[13], (DEPTH, D_MODEL, FFN_HIDDEN), D_MODEL),
        "w_up": nrm(ks[14], (DEPTH, D_MODEL, FFN_HIDDEN), D_MODEL),
        "w_down": nrm(ks[15], (DEPTH, FFN_HIDDEN, D_MODEL), FFN_HIDDEN),
        "final_g": gain(ks[16], (D_MODEL,)),
    }


def reference(x, norm1_g, w_in, cmp_pe_k, cmp_w1_k, cmp_w2_k, cmp_pe_v, cmp_w1_v, cmp_w2_v,
              grp_norm_a, grp_norm_b, w_out, norm2_g, w_gate, w_up, w_down, final_g):
    B, S, _ = x.shape
    G, Hq = NSA_KV_GROUPS, NSA_HPG
    slopes = alibi_slopes(N_HEADS)
    slopes_a = slopes[0::2]
    slopes_b = slopes[1::2].reshape(G, Hq)
    offsets = np.cumsum(COL_SIZES)[:-1].tolist()
    h = x
    for l in range(DEPTH):
        hn = rmsnorm(h, norm1_g[l])
        proj = hn @ w_in[l]
        (q_a, k_a, v_a, q_b, k_c, v_c, k_s, v_s, k_w, v_w, g_b) = jnp.split(proj, offsets, axis=-1)

        o_a = dilated_mixture(split_heads(q_a, N_HEADS_A), split_heads(k_a, N_HEADS_A),
                              split_heads(v_a, N_HEADS_A), slopes_a)
        o_a = o_a.transpose(0, 2, 1, 3).reshape(B, S, WIDTH_A)

        qb = split_heads(q_b, N_HEADS_B).reshape(B, G, Hq, S, HEAD_DIM)
        kc_raw, vc_raw = split_heads(k_c, G), split_heads(v_c, G)
        kc = compress_blocks(kc_raw, cmp_pe_k[l], cmp_w1_k[l], cmp_w2_k[l])
        vc = compress_blocks(vc_raw, cmp_pe_v[l], cmp_w1_v[l], cmp_w2_v[l])
        o_cmp, p_cmp = nsa_compressed(qb, kc, vc, slopes_b)
        o_sel = nsa_selected(qb, split_heads(k_s, G), split_heads(v_s, G), p_cmp, slopes_b)
        o_win = nsa_window(qb, split_heads(k_w, G), split_heads(v_w, G), slopes_b)
        gates = jax.nn.sigmoid(g_b.reshape(B, S, N_HEADS_B, N_GATES)).transpose(0, 2, 1, 3)
        gates = gates.reshape(B, G, Hq, S, N_GATES)
        o_b = (gates[..., 0:1] * o_cmp + gates[..., 1:2] * o_sel + gates[..., 2:3] * o_win)
        o_b = o_b.reshape(B, N_HEADS_B, S, HEAD_DIM).transpose(0, 2, 1, 3).reshape(B, S, WIDTH_B)

        mixed = jnp.concatenate([rmsnorm(o_a, grp_norm_a[l]), rmsnorm(o_b, grp_norm_b[l])], axis=-1)
        h = h + mixed @ w_out[l]

        hn2 = rmsnorm(h, norm2_g[l])
        h = h + (jax.nn.silu(hn2 @ w_gate[l]) * (hn2 @ w_up[l])) @ w_down[l]
    return rmsnorm(h, final_g)
```

```cpp
#include <hip/hip_runtime.h>
#include <hip/hip_cooperative_groups.h>
#include <cstdio>
#include <cstdint>
namespace cg = cooperative_groups;

#define LAS __attribute__((address_space(3)))
typedef unsigned short bf16_t;
typedef short bf16x8 __attribute__((ext_vector_type(8)));
typedef float f32x4 __attribute__((ext_vector_type(4)));
typedef unsigned u32x4 __attribute__((ext_vector_type(4)));
typedef unsigned u32x2 __attribute__((ext_vector_type(2)));

constexpr int T_ = 16384, S_ = 4096, DM = 2048, PIN = 5656, NP = 5888, FF = 5632;
constexpr float EPS = 1e-6f;
constexpr float LOG2E = 1.4426950408889634f, LN2 = 0.6931471805599453f;
constexpr float C2 = 0.08838834764831845f * 1.4426950408889634f;

constexpr size_t al256(size_t x) { return (x + 255) & ~(size_t)255; }
constexpr size_t WS_CTL = 0;
constexpr size_t WS_BAR = 2048;
constexpr size_t WS_RSQ2 = 4096;
constexpr size_t WS_RSQ3 = WS_RSQ2 + (size_t)T_ * 4;
constexpr size_t WS_BIASC = WS_RSQ3 + (size_t)T_ * 4;
constexpr size_t WS_BIASP = al256(WS_BIASC + 2048);
constexpr size_t WS_WIN = al256(WS_BIASP + 131072);
constexpr size_t WS_WOUT = WS_WIN + (size_t)NP * DM * 2;
constexpr size_t WS_WGU = WS_WOUT + (size_t)DM * DM * 2;
constexpr size_t WS_WDN = WS_WGU + (size_t)2 * FF * DM * 2;
constexpr size_t WS_WC1 = WS_WDN + (size_t)DM * FF * 2;
constexpr size_t WS_W2T = WS_WC1 + (size_t)2 * 256 * 4096 * 2;
constexpr size_t WS_HID = WS_W2T + (size_t)2 * 128 * 256 * 2;
constexpr size_t WS_KVC = WS_HID + (size_t)2 * 8 * 256 * 256 * 2;
constexpr size_t WS_LSE = WS_KVC + (size_t)2 * 8 * 256 * 128 * 2;
constexpr size_t WS_R1 = WS_LSE + (size_t)3 * T_ * 8 * 4;
constexpr int NQ = 2304;
constexpr size_t WS_PROJ = WS_R1 + (size_t)T_ * DM * 2;
constexpr size_t WS_KVA = WS_PROJ + (size_t)T_ * NQ * 2;
constexpr size_t WS_KVS = WS_KVA + (size_t)2 * 4 * 8 * 4096 * 128 * 2;
constexpr size_t WS_CRAW = WS_KVS + (size_t)4 * 4 * 2 * 4096 * 128 * 2;
constexpr size_t WS_OB = WS_CRAW + (size_t)2 * 8 * 4096 * 128 * 2 + 16384;
constexpr size_t WS_END = WS_OB + (size_t)3 * T_ * 1024 * 2;
static_assert(WS_OB - WS_PROJ >= (size_t)T_ * FF * 2, "act overlay");
static_assert(WS_END <= (size_t)536870912, "workspace");

constexpr int LDS_BYTES = 131072 + 1024;
constexpr int LDS_SLOT = 131072;

typedef __bf16 bf16v2 __attribute__((ext_vector_type(2)));
typedef float f32x2 __attribute__((ext_vector_type(2)));
__device__ __forceinline__ unsigned cvt_pk_bf16(float lo, float hi) { f32x2 v = {lo, hi}; bf16v2 b = __builtin_convertvector(v, bf16v2); return __builtin_bit_cast(unsigned, b); }
__device__ __forceinline__ float bf_lo(unsigned w) { return __uint_as_float(w << 16); }
__device__ __forceinline__ float bf_hi(unsigned w) { return __uint_as_float(w & 0xffff0000u); }
__device__ __forceinline__ float bf1(bf16_t b) { return __uint_as_float(((unsigned)b) << 16); }
__device__ __forceinline__ float wave_sum(float v) {
#pragma unroll
    for (int o = 1; o < 64; o <<= 1) v += __shfl_xor(v, o);
    return v;
}

namespace pg8 {
constexpr int BM = 256, BK = 64, HALF = 128, HTB = HALF * BK * 2, STAGE_BYTES = 8 * HTB, NXCD = 8, WGM = 4;
__host__ __device__ __forceinline__ int lds_byte(int r, int c) { const int st = (r >> 4) * 2 + (c >> 5), rr = r & 15, cc = c & 31, ob = rr * 64 + cc * 2; return st * 1024 + (ob ^ (((ob >> 9) & 1) << 5)); }
__host__ __device__ __forceinline__ void stage_rc(int b, int& R, int& C) { const int st = b / 1024, sb = b % 1024, swz = sb ^ (((sb >> 9) & 1) << 5); R = (st >> 1) * 16 + swz / 64; C = (st & 1) * 32 + (swz % 64) / 2; }
__host__ __device__ __forceinline__ int perm32(int rho) { const int n = rho >> 4, i = rho & 15; return 8 * (i >> 2) + 4 * n + (i & 3); }
struct Unit { int pm, pn; };
struct Gemm { const bf16_t* A; const bf16_t* Bt; int M, N, K, lda, ldb; };
struct StaticOrder {
    int nM, nN, nwg, G, c;
    __device__ void init(int M, int N, int G_, int c_) { nM = M / BM; nN = N / BM; nwg = nM * nN; G = G_; c = c_; }
    __device__ bool next(int i, Unit& u) const {
        const long L = (long)i * G + c; if (L >= nwg) return false;
        int wgid = (int)L; { const int q = nwg / NXCD, r = nwg % NXCD, xcd = wgid % NXCD, off = wgid / NXCD; wgid = (xcd < r ? xcd * (q + 1) : r * (q + 1) + (xcd - r) * q) + off; }
        const int nig = WGM * nN, gid = wgid / nig, fm = gid * WGM, gsz = (nM - fm) < WGM ? (nM - fm) : WGM;
        u.pm = fm + ((wgid % nig) % gsz); u.pn = (wgid % nig) / gsz; return true;
    }
};
struct SingleOrder {
    int pm;
    __device__ bool next(int i, Unit& u) const { if (i != 0) return false; u.pm = pm; u.pn = 0; return true; }
};

template <class Epi, class Sched>
__device__ __forceinline__ void gemm_phase(LAS unsigned char* lds, const Gemm g, const Sched& S, const Epi& E) {
    int tid_ = threadIdx.x; asm volatile("" : "+v"(tid_));
    const int tid = tid_, wid = __builtin_amdgcn_readfirstlane(tid >> 6), lane = tid & 63, wr = wid >> 2, wc = wid & 3, fr = lane & 15, fq = lane >> 4;
    const int K = g.K, nt = K / BK;
    unsigned voffA[2], voffB[2];
#pragma unroll
    for (int i = 0; i < 2; ++i) { int R, C; stage_rc(tid * 16 + i * 8192, R, C);
        const int Rb = (R & ~31) + perm32(R & 31);
        voffA[i] = (unsigned)(R * g.lda + C) * 2u; voffB[i] = (unsigned)(Rb * g.ldb + C) * 2u; }
    const size_t kstep = (size_t)(BK * 2);
    const size_t hstepA = (size_t)HALF * g.lda * 2, hstepB = (size_t)HALF * g.ldb * 2;
    const size_t tstepA = 2 * hstepA, tstepB = 2 * hstepB;
    const unsigned ldsw = (unsigned)wid * 1024u;
    const int aoff = lds_byte(wr * 64 + fr, fq * 8), boff = lds_byte(wc * 32 + fr, fq * 8);
#define PG8_SA(b, h) (((b) * 2 + (h)) * HTB)
#define PG8_SB(b, h) ((4 + (b) * 2 + (h)) * HTB)
#define PG8_STAGE(bufoff, gbase, voff) do { _Pragma("unroll") for (int _i = 0; _i < 2; ++_i) \
        __builtin_amdgcn_global_load_lds((const unsigned*)((const char*)(gbase) + (voff)[_i]), (LAS unsigned*)(lds + (bufoff) + ldsw + _i * 8192), 16, 0, 0); } while (0)
#define PG8_LDA(dst, b, h) do { _Pragma("unroll") for (int m = 0; m < 4; ++m) _Pragma("unroll") for (int k = 0; k < 2; ++k) dst[m][k] = *(const LAS bf16x8*)(lds + PG8_SA(b, h) + aoff + m * 2048 + k * 1024); } while (0)
#define PG8_LDB(dst, b, h) do { _Pragma("unroll") for (int n = 0; n < 2; ++n) _Pragma("unroll") for (int k = 0; k < 2; ++k) dst[n][k] = *(const LAS bf16x8*)(lds + PG8_SB(b, h) + boff + n * 2048 + k * 1024); } while (0)
#define PG8_MMA(ai, bj, At, Bt) do { __builtin_amdgcn_s_setprio(1); _Pragma("unroll") for (int m = 0; m < 4; ++m) _Pragma("unroll") for (int n = 0; n < 2; ++n) _Pragma("unroll") for (int k = 0; k < 2; ++k) \
        acc[ai][bj][m][n] = __builtin_amdgcn_mfma_f32_16x16x32_bf16(Bt[n][k], At[m][k], acc[ai][bj][m][n], 0, 0, 0); __builtin_amdgcn_s_setprio(0); } while (0)
#define PG8_WAIT_V(n) asm volatile("s_waitcnt vmcnt(" #n ")" ::: "memory")
#define PG8_WAIT_L(n) asm volatile("s_waitcnt lgkmcnt(" #n ")" ::: "memory")
#define PG8_BAR __builtin_amdgcn_s_barrier()
#define PG8_SCHED __builtin_amdgcn_sched_barrier(0)
    Unit cur, nxt; int ui = 0;
    if (!S.next(0, cur)) return;
    f32x4 acc[2][2][4][2];
#pragma unroll
    for (int a = 0; a < 2; ++a)
#pragma unroll
        for (int b = 0; b < 2; ++b)
#pragma unroll
            for (int m = 0; m < 4; ++m)
#pragma unroll
                for (int n = 0; n < 2; ++n) acc[a][b][m][n] = (f32x4){0.f, 0.f, 0.f, 0.f};
    bf16x8 At[4][2], B0[2][2], B1[2][2];
    const char* cA = (const char*)g.A + (size_t)cur.pm * tstepA; const char* cB = (const char*)g.Bt + (size_t)cur.pn * tstepB;
    PG8_STAGE(PG8_SB(0, 0), cB, voffB); PG8_STAGE(PG8_SB(0, 1), cB + hstepB, voffB); PG8_STAGE(PG8_SA(0, 0), cA, voffA); PG8_STAGE(PG8_SA(0, 1), cA + hstepA, voffA);
    if (wr == 1) PG8_BAR;
    PG8_WAIT_V(2); PG8_BAR;
    PG8_STAGE(PG8_SB(1, 0), cB + kstep, voffB); PG8_STAGE(PG8_SA(1, 0), cA + kstep, voffA); PG8_STAGE(PG8_SB(1, 1), cB + hstepB + kstep, voffB);
    PG8_WAIT_V(6); PG8_BAR;
    for (;;) {
        const bool has_next = S.next(ui + 1, nxt);
        const char* nA = has_next ? (const char*)g.A + (size_t)nxt.pm * tstepA : cA; const char* nB = has_next ? (const char*)g.Bt + (size_t)nxt.pn * tstepB : cB;
        for (int t = 0; t < nt; t += 2) {
            const bool last = (t == nt - 2);
            const char* a1 = cA + (size_t)(t + 1) * kstep;
            const char* a2 = last ? nA : cA + (size_t)(t + 2) * kstep; const char* b2 = last ? nB : cB + (size_t)(t + 2) * kstep;
            const char* a3 = a2 + kstep; const char* b3 = b2 + kstep;
            PG8_LDB(B0, 0, 0); PG8_LDB(B1, 0, 1); PG8_SCHED; PG8_LDA(At, 0, 0); PG8_STAGE(PG8_SA(1, 1), a1 + hstepA, voffA);
            PG8_WAIT_V(8); PG8_WAIT_L(0); PG8_BAR; PG8_MMA(0, 0, At, B0); PG8_MMA(0, 1, At, B1); PG8_BAR; PG8_SCHED;
            PG8_LDA(At, 0, 1); PG8_STAGE(PG8_SB(0, 0), b2, voffB); PG8_STAGE(PG8_SB(0, 1), b2 + hstepB, voffB); PG8_STAGE(PG8_SA(0, 0), a2, voffA);
            PG8_WAIT_V(8); PG8_WAIT_L(0); PG8_BAR; PG8_MMA(1, 0, At, B0); PG8_MMA(1, 1, At, B1); PG8_BAR; PG8_SCHED;
            PG8_LDB(B0, 1, 0); PG8_LDB(B1, 1, 1); PG8_SCHED; PG8_LDA(At, 1, 0); PG8_STAGE(PG8_SA(0, 1), a2 + hstepA, voffA);
            PG8_WAIT_V(8); PG8_WAIT_L(0); PG8_BAR; PG8_MMA(0, 0, At, B0); PG8_MMA(0, 1, At, B1); PG8_BAR; PG8_SCHED;
            PG8_LDA(At, 1, 1); PG8_STAGE(PG8_SB(1, 0), b3, voffB); PG8_STAGE(PG8_SB(1, 1), b3 + hstepB, voffB); PG8_STAGE(PG8_SA(1, 0), a3, voffA);
            PG8_WAIT_V(8); PG8_WAIT_L(0); PG8_BAR; PG8_MMA(1, 0, At, B0); PG8_MMA(1, 1, At, B1); PG8_BAR; PG8_SCHED;
        }
        if (wr == 0) PG8_BAR;
        E(acc, cur, wr, wc, fr, fq);
        if (!has_next) break;
#pragma unroll
        for (int a = 0; a < 2; ++a)
#pragma unroll
            for (int b = 0; b < 2; ++b)
#pragma unroll
                for (int m = 0; m < 4; ++m)
#pragma unroll
                    for (int n = 0; n < 2; ++n) acc[a][b][m][n] = (f32x4){0.f, 0.f, 0.f, 0.f};
        cur = nxt; cA = nA; cB = nB; ++ui;
        if (wr == 1) PG8_BAR;
    }
    PG8_WAIT_V(0);
    PG8_BAR;
#undef PG8_SA
#undef PG8_SB
#undef PG8_STAGE
#undef PG8_LDA
#undef PG8_LDB
#undef PG8_MMA
#undef PG8_WAIT_V
#undef PG8_WAIT_L
#undef PG8_BAR
#undef PG8_SCHED
}
}

typedef f32x4 Acc[2][2][4][2];

struct EpiProj {
    bf16_t* projq; bf16_t* kva; bf16_t* kvs; bf16_t* craw;
    __device__ __forceinline__ void operator()(const Acc& acc, const pg8::Unit& u, int wr, int wc, int fr, int fq) const {
        const int pn = u.pn;
        bf16_t* base; long SJ, SB, ST;
        if (pn < 4)       { base = projq + pn * 256;                                   SJ = 128; SB = (long)4096 * NQ; ST = NQ; }
        else if (pn < 8)  { base = kva + (size_t)((pn - 4) * 2) * 4096 * 128;          SJ = (long)4096 * 128; SB = (long)8 * 4096 * 128; ST = 128; }
        else if (pn < 12) { base = kva + (size_t)4 * 8 * 4096 * 128 + (size_t)((pn - 8) * 2) * 4096 * 128; SJ = (long)4096 * 128; SB = (long)8 * 4096 * 128; ST = 128; }
        else if (pn < 16) { base = projq + 1024 + (pn - 12) * 256;                     SJ = 128; SB = (long)4096 * NQ; ST = NQ; }
        else if (pn < 18) { base = craw + (size_t)(pn - 16) * (8 * 4096 * 128);        SJ = (long)4096 * 128; SB = (long)2 * 4096 * 128; ST = 128; }
        else if (pn < 22) { base = kvs + (size_t)(pn - 18) * (4 * 2 * 4096 * 128);     SJ = (long)4096 * 128; SB = (long)2 * 4096 * 128; ST = 128; }
        else              { base = projq + 2048;                                       SJ = 128; SB = (long)4096 * NQ; ST = NQ; }
        const int row0 = u.pm * 256 + wr * 64 + fr;
        bf16_t* lanep = base + (long)(row0 >> 12) * SB + (long)(row0 & 4095) * ST + wc * 32 + fq * 8;
#pragma unroll
        for (int ai = 0; ai < 2; ++ai)
#pragma unroll
            for (int m = 0; m < 4; ++m) {
                bf16_t* rowp = lanep + (long)(ai * 128 + m * 16) * ST;
#pragma unroll
                for (int bj = 0; bj < 2; ++bj) {
                    const f32x4 v0 = acc[ai][bj][m][0], v1 = acc[ai][bj][m][1];
                    u32x4 w; w.x = cvt_pk_bf16(v0[0], v0[1]); w.y = cvt_pk_bf16(v0[2], v0[3]); w.z = cvt_pk_bf16(v1[0], v1[1]); w.w = cvt_pk_bf16(v1[2], v1[3]);
                    *(u32x4*)(rowp + bj * SJ) = w;
                }
            }
    }
};
struct EpiHid {
    bf16_t* hid; const float* bias;
    __device__ __forceinline__ void operator()(const Acc& acc, const pg8::Unit& u, int wr, int wc, int fr, int fq) const {
#pragma unroll
        for (int bj = 0; bj < 2; ++bj)
#pragma unroll
            for (int n = 0; n < 2; ++n) {
                const int col = bj * 128 + wc * 32 + fq * 8 + n * 4;
                const f32x4 bv = *(const f32x4*)(bias + col);
#pragma unroll
                for (int ai = 0; ai < 2; ++ai)
#pragma unroll
                    for (int m = 0; m < 4; ++m) {
                        const int row = ai * 128 + wr * 64 + m * 16 + fr;
                        f32x4 v = acc[ai][bj][m][n] + bv;
#pragma unroll
                        for (int j = 0; j < 4; ++j) v[j] = v[j] * __builtin_amdgcn_rcpf(1.f + __expf(-v[j]));
                        u32x2 w; w.x = cvt_pk_bf16(v[0], v[1]); w.y = cvt_pk_bf16(v[2], v[3]);
                        *(u32x2*)(hid + (size_t)row * 256 + col) = w;
                    }
            }
    }
};
struct EpiWout {
    const float* x; bf16_t* hb; float* rsq;
    __device__ __forceinline__ void operator()(const Acc& acc, const pg8::Unit& u, int wr, int wc, int fr, int fq) const {
#pragma unroll
        for (int ai = 0; ai < 2; ++ai)
#pragma unroll
            for (int m = 0; m < 4; ++m) {
                const int row = u.pm * 256 + ai * 128 + wr * 64 + m * 16 + fr;
                float ss = 0.f;
#pragma unroll
                for (int bj = 0; bj < 2; ++bj) {
                    const size_t off = (size_t)row * DM + u.pn * 256 + bj * 128 + wc * 32 + fq * 8;
                    const f32x4 h0 = *(const f32x4*)(x + off) + acc[ai][bj][m][0], h1 = *(const f32x4*)(x + off + 4) + acc[ai][bj][m][1];
                    u32x4 w; w.x = cvt_pk_bf16(h0[0], h0[1]); w.y = cvt_pk_bf16(h0[2], h0[3]); w.z = cvt_pk_bf16(h1[0], h1[1]); w.w = cvt_pk_bf16(h1[2], h1[3]);
                    *(u32x4*)(hb + off) = w;
                    ss += (h0[0] * h0[0] + h0[1] * h0[1]) + (h0[2] * h0[2] + h0[3] * h0[3]) + (h1[0] * h1[0] + h1[1] * h1[1]) + (h1[2] * h1[2] + h1[3] * h1[3]);
                }
                ss += __shfl_xor(ss, 16); ss += __shfl_xor(ss, 32);
                if (fq == 0) atomicAdd(rsq + row, ss);
            }
    }
};
struct EpiSwiglu {
    bf16_t* act; const float* rsq;
    __device__ __forceinline__ void operator()(const Acc& acc, const pg8::Unit& u, int wr, int wc, int fr, int fq) const {
#pragma unroll
        for (int ai = 0; ai < 2; ++ai)
#pragma unroll
            for (int m = 0; m < 4; ++m) {
                const int row = u.pm * 256 + ai * 128 + wr * 64 + m * 16 + fr;
                const float r = rsqrtf(rsq[row] * (1.f / DM) + EPS);
                u32x4 w;
#pragma unroll
                for (int n = 0; n < 2; ++n) {
                    const f32x4 g = acc[ai][0][m][n] * r, up = acc[ai][1][m][n] * r;
                    f32x4 a;
#pragma unroll
                    for (int j = 0; j < 4; ++j) a[j] = g[j] * __builtin_amdgcn_rcpf(1.f + __expf(-g[j])) * up[j];
                    w[2 * n] = cvt_pk_bf16(a[0], a[1]); w[2 * n + 1] = cvt_pk_bf16(a[2], a[3]);
                }
                *(u32x4*)(act + (size_t)row * FF + u.pn * 128 + wc * 32 + fq * 8) = w;
            }
    }
};
struct EpiDown {
    const bf16_t* hb; bf16_t* out; float* rsq;
    __device__ __forceinline__ void operator()(const Acc& acc, const pg8::Unit& u, int wr, int wc, int fr, int fq) const {
#pragma unroll
        for (int ai = 0; ai < 2; ++ai)
#pragma unroll
            for (int m = 0; m < 4; ++m) {
                const int row = u.pm * 256 + ai * 128 + wr * 64 + m * 16 + fr;
                float ss = 0.f;
#pragma unroll
                for (int bj = 0; bj < 2; ++bj) {
                    const size_t off = (size_t)row * DM + u.pn * 256 + bj * 128 + wc * 32 + fq * 8;
                    const u32x4 hw = *(const u32x4*)(hb + off);
                    f32x4 y0 = acc[ai][bj][m][0], y1 = acc[ai][bj][m][1];
                    y0[0] += bf_lo(hw.x); y0[1] += bf_hi(hw.x); y0[2] += bf_lo(hw.y); y0[3] += bf_hi(hw.y);
                    y1[0] += bf_lo(hw.z); y1[1] += bf_hi(hw.z); y1[2] += bf_lo(hw.w); y1[3] += bf_hi(hw.w);
                    { u32x4 w; w.x = cvt_pk_bf16(y0[0], y0[1]); w.y = cvt_pk_bf16(y0[2], y0[3]); w.z = cvt_pk_bf16(y1[0], y1[1]); w.w = cvt_pk_bf16(y1[2], y1[3]); *(u32x4*)(out + off) = w; }
                    ss += (y0[0] * y0[0] + y0[1] * y0[1]) + (y0[2] * y0[2] + y0[3] * y0[3]) + (y1[0] * y1[0] + y1[1] * y1[1]) + (y1[2] * y1[2] + y1[3] * y1[3]);
                }
                ss += __shfl_xor(ss, 16); ss += __shfl_xor(ss, 32);
                if (fq == 0) atomicAdd(rsq + row, ss);
            }
    }
};

constexpr int KP = 136, VPN = 144;
constexpr int LDS_K = 0, LDS_V = 64 * KP * 2;
constexpr int LDS_SCO = 36864;
constexpr int LDS_WU = LDS_SCO + 8 * 2048;

struct Stage { u32x4 k0, k1, v0, v1; };
__device__ __forceinline__ void stage_load(Stage& st, const bf16_t* kb, const bf16_t* vb, long pitch, int tid) {
    const int p0 = tid, p1 = tid + 512;
    st.k0 = *(const u32x4*)(kb + (long)(p0 >> 4) * pitch + (p0 & 15) * 8);
    st.k1 = *(const u32x4*)(kb + (long)(p1 >> 4) * pitch + (p1 & 15) * 8);
    st.v0 = *(const u32x4*)(vb + (long)(p0 >> 4) * pitch + (p0 & 15) * 8);
    st.v1 = *(const u32x4*)(vb + (long)(p1 >> 4) * pitch + (p1 & 15) * 8);
}
__device__ __forceinline__ void stage_load_k(Stage& st, const bf16_t* kb, long pitch, int tid) {
    const int p0 = tid, p1 = tid + 512;
    st.k0 = *(const u32x4*)(kb + (long)(p0 >> 4) * pitch + (p0 & 15) * 8);
    st.k1 = *(const u32x4*)(kb + (long)(p1 >> 4) * pitch + (p1 & 15) * 8);
}
__device__ __forceinline__ void stage_store_k(const Stage& st, LAS unsigned char* lds, int tid) {
    const int p0 = tid, p1 = tid + 512;
    *(LAS u32x4*)(lds + LDS_K + (p0 >> 4) * (KP * 2) + (p0 & 15) * 16) = st.k0;
    *(LAS u32x4*)(lds + LDS_K + (p1 >> 4) * (KP * 2) + (p1 & 15) * 16) = st.k1;
}
__device__ __forceinline__ void stage_store(const Stage& st, LAS unsigned char* lds, int tid) {
    const int p0 = tid, p1 = tid + 512;
    *(LAS u32x4*)(lds + LDS_K + (p0 >> 4) * (KP * 2) + (p0 & 15) * 16) = st.k0;
    *(LAS u32x4*)(lds + LDS_K + (p1 >> 4) * (KP * 2) + (p1 & 15) * 16) = st.k1;
    *(LAS u32x4*)(lds + LDS_V + (p0 >> 4) * (VPN * 2) + (p0 & 15) * 16) = st.v0;
    *(LAS u32x4*)(lds + LDS_V + (p1 >> 4) * (VPN * 2) + (p1 & 15) * 16) = st.v1;
}
template <int NRG>
__device__ __forceinline__ void qk_tile(LAS unsigned char* lds, const bf16x8 (&qf)[NRG][4], f32x4 (&sc)[NRG][4], int fr, int fq) {
#pragma unroll
    for (int s = 0; s < 4; ++s) {
#pragma unroll
        for (int rg = 0; rg < NRG; ++rg) sc[rg][s] = (f32x4){0.f, 0.f, 0.f, 0.f};
#pragma unroll
        for (int kk = 0; kk < 4; ++kk) {
            const bf16x8 kf = *(const LAS bf16x8*)(lds + LDS_K + (s * 16 + fr) * (KP * 2) + kk * 64 + fq * 16);
#pragma unroll
            for (int rg = 0; rg < NRG; ++rg) sc[rg][s] = __builtin_amdgcn_mfma_f32_16x16x32_bf16(kf, qf[rg][kk], sc[rg][s], 0, 0, 0);
        }
    }
}
typedef short s16x4 __attribute__((ext_vector_type(4)));
template <int NRG>
__device__ __forceinline__ void pv_tile(LAS unsigned char* lds, const bf16x8 (&pb)[NRG][2], f32x4 (&o)[NRG][8], int fr, int fq) {
    LAS unsigned char* vbase = lds + LDS_V + (4 * fq + (fr >> 2)) * (VPN * 2) + (fr & 3) * 8;
#pragma unroll
    for (int c = 0; c < 8; ++c)
#pragma unroll
        for (int u = 0; u < 2; ++u) {
            const s16x4 lo = __builtin_amdgcn_ds_read_tr16_b64_v4i16((LAS s16x4*)(vbase + (32 * u) * (VPN * 2) + c * 32));
            const s16x4 hi = __builtin_amdgcn_ds_read_tr16_b64_v4i16((LAS s16x4*)(vbase + (32 * u + 16) * (VPN * 2) + c * 32));
            const bf16x8 vf = {lo[0], lo[1], lo[2], lo[3], hi[0], hi[1], hi[2], hi[3]};
#pragma unroll
            for (int rg = 0; rg < NRG; ++rg) o[rg][c] = __builtin_amdgcn_mfma_f32_16x16x32_bf16(vf, pb[rg][u], o[rg][c], 0, 0, 0);
        }
}
__device__ __forceinline__ bf16x8 pack8(const f32x4 a, const f32x4 b) {
    u32x4 w = {cvt_pk_bf16(a[0], a[1]), cvt_pk_bf16(a[2], a[3]), cvt_pk_bf16(b[0], b[1]), cvt_pk_bf16(b[2], b[3])};
    return *reinterpret_cast<bf16x8*>(&w);
}
__device__ __forceinline__ void softmax_update(f32x4 (&x)[4], float& m, float& l, f32x4 (&o)[8], bf16x8 (&pb)[2]) {
    float mx = x[0][0];
#pragma unroll
    for (int s = 0; s < 4; ++s)
#pragma unroll
        for (int r = 0; r < 4; ++r) mx = fmaxf(mx, x[s][r]);
    mx = fmaxf(mx, __shfl_xor(mx, 16)); mx = fmaxf(mx, __shfl_xor(mx, 32));
    const float mn = fmaxf(m, mx);
    const float alpha = __builtin_amdgcn_exp2f(m - mn);
    m = mn;
    float ls = 0.f;
#pragma unroll
    for (int s = 0; s < 4; ++s)
#pragma unroll
        for (int r = 0; r < 4; ++r) { x[s][r] = __builtin_amdgcn_exp2f(x[s][r] - mn); ls += x[s][r]; }
    l = l * alpha + ls;
#pragma unroll
    for (int c = 0; c < 8; ++c) o[c] *= alpha;
    pb[0] = pack8(x[0], x[1]); pb[1] = pack8(x[2], x[3]);
}
template <bool MASK>
__device__ __forceinline__ void softmax_tile(f32x4 (&x)[4], float slope2, float base, int relb, unsigned W, float& m, float& l, f32x4 (&o)[8], bf16x8 (&pb)[2]) {
    float mx = -__builtin_inff();
#pragma unroll
    for (int s = 0; s < 4; ++s)
#pragma unroll
        for (int r = 0; r < 4; ++r) {
            const int k = 16 * s + r;
            float y = fmaf(x[s][r], C2, fmaf(slope2, (float)k, base));
            if (MASK) y = ((unsigned)(relb - k) <= W) ? y : -__builtin_inff();
            x[s][r] = y; mx = fmaxf(mx, y);
        }
    mx = fmaxf(mx, __shfl_xor(mx, 16)); mx = fmaxf(mx, __shfl_xor(mx, 32));
    float mn = m;
    if (!__all(mx - m <= 8.f)) {
        mn = fmaxf(m, mx);
        const float alpha = __builtin_amdgcn_exp2f(m - mn);
        m = mn; l *= alpha;
#pragma unroll
        for (int c = 0; c < 8; ++c) o[c] *= alpha;
    }
    float ls = 0.f;
#pragma unroll
    for (int s = 0; s < 4; ++s)
#pragma unroll
        for (int r = 0; r < 4; ++r) { x[s][r] = __builtin_amdgcn_exp2f(x[s][r] - mn); ls += x[s][r]; }
    l += ls;
    pb[0] = pack8(x[0], x[1]); pb[1] = pack8(x[2], x[3]);
}
__device__ __forceinline__ void store_o_row(bf16_t* dst, const f32x4 (&o)[8], float inv, int fq) {
#pragma unroll
    for (int c = 0; c < 8; ++c) {
        u32x2 w; w.x = cvt_pk_bf16(o[c][0] * inv, o[c][1] * inv); w.y = cvt_pk_bf16(o[c][2] * inv, o[c][3] * inv);
        *(u32x2*)(dst + c * 16 + fq * 4) = w;
    }
}

__device__ __forceinline__ void band_job(LAS unsigned char* lds, const bf16_t* qb, long qpitch, const bf16_t* kb, const bf16_t* vb, long kvpitch,
                                         int q0, int W, float slope2, bf16_t* ob, long opitch, float* lseb, long lsepitch) {
    int tid_ = threadIdx.x; asm volatile("" : "+v"(tid_));
    const int tid = tid_, wid = __builtin_amdgcn_readfirstlane(tid >> 6), lane = tid & 63, fr = lane & 15, fq = lane >> 4;
    bf16x8 qf[2][4]; f32x4 o[2][8]; float m[2], l[2]; int qi[2];
#pragma unroll
    for (int rg = 0; rg < 2; ++rg) {
        qi[rg] = q0 + wid * 32 + rg * 16 + fr;
#pragma unroll
        for (int kk = 0; kk < 4; ++kk) qf[rg][kk] = *(const bf16x8*)(qb + (long)qi[rg] * qpitch + kk * 32 + fq * 8);
#pragma unroll
        for (int c = 0; c < 8; ++c) o[rg][c] = (f32x4){0.f, 0.f, 0.f, 0.f};
        m[rg] = -1e30f; l[rg] = 0.f;
    }
    const int qa = q0 + wid * 32;
    const int kt_lo = (q0 - W > 0 ? q0 - W : 0) >> 6, kt_hi = (q0 + 255) >> 6;
    Stage st; stage_load(st, kb + (long)(kt_lo * 64) * kvpitch, vb + (long)(kt_lo * 64) * kvpitch, kvpitch, tid);
    for (int kt = kt_lo; kt <= kt_hi; ++kt) {
        __syncthreads();
        stage_store(st, lds, tid);
        __syncthreads();
        if (kt < kt_hi) stage_load(st, kb + (long)((kt + 1) * 64) * kvpitch, vb + (long)((kt + 1) * 64) * kvpitch, kvpitch, tid);
        const bool need = (kt * 64 <= qa + 31) && (kt * 64 + 63 >= qa - W);
        if (need) {
            bf16x8 pb[2][2]; f32x4 sc[2][4];
            qk_tile<2>(lds, qf, sc, fr, fq);
#pragma unroll
            for (int rg = 0; rg < 2; ++rg) {
                const int relb = qi[rg] - kt * 64 - fq * 4;
                const float base = -slope2 * (float)relb;
                softmax_tile<true>(sc[rg], slope2, base, relb, (unsigned)W, m[rg], l[rg], o[rg], pb[rg]);
            }
            pv_tile<2>(lds, pb, o, fr, fq);
        }
    }
#pragma unroll
    for (int rg = 0; rg < 2; ++rg) {
        float lt = l[rg]; lt += __shfl_xor(lt, 16); lt += __shfl_xor(lt, 32);
        const float inv = lt > 0.f ? 1.f / lt : 0.f;
        store_o_row(ob + (long)qi[rg] * opitch, o[rg], inv, fq);
        if (lseb && fq == 0) lseb[(long)qi[rg] * lsepitch] = (m[rg] + __log2f(lt)) * LN2;
    }
}

__device__ __forceinline__ void nsa_job(LAS unsigned char* lds, const bf16_t* proj, const bf16_t* ksv, const bf16_t* kc, const bf16_t* vc, bf16_t* ocmp, bf16_t* osel, int b, int g, int chunk, int half, bool dry = false) {
    int tid_ = threadIdx.x; asm volatile("" : "+v"(tid_));
    const int tid = tid_, wid = __builtin_amdgcn_readfirstlane(tid >> 6), lane = tid & 63, fr = lane & 15, fq = lane >> 4;
    const int t0 = chunk * 64, tq = t0 + half * 32 + wid * 4 + (fr & 3);
    const int head = fr >> 2, hq = g * 4 + head;
    const size_t rowbase = (size_t)(b * S_ + tq);
    const float slope2 = __builtin_amdgcn_exp2f(-(float)(hq + 1)) * LOG2E;
    bf16x8 qf[1][4]; f32x4 o[1][8]; float m = -1e30f, l = 0.f;
#pragma unroll
    for (int kk = 0; kk < 4; ++kk) qf[0][kk] = *(const bf16x8*)(proj + rowbase * NQ + 1024 + hq * 128 + kk * 32 + fq * 8);
    const bf16_t* kcb = kc + (size_t)(b * 2 + g) * 256 * 128; const bf16_t* vcb = vc + (size_t)(b * 2 + g) * 256 * 128;
    const int cmax = (t0 + 32) >> 4;
    const int ktc = (cmax >> 6) > 3 ? 3 : (cmax >> 6);
    Stage stA, stB;
    float imp[16];
#pragma unroll
    for (int i = 0; i < 16; ++i) imp[i] = 0.f;
#pragma unroll
    for (int c = 0; c < 8; ++c) o[0][c] = (f32x4){0.f, 0.f, 0.f, 0.f};
    {
        stage_load(stA, kcb, vcb, 128, tid);
        if (ktc >= 1) stage_load(stB, kcb + (size_t)64 * 128, vcb + (size_t)64 * 128, 128, tid);
#pragma unroll
        for (int kt = 0; kt < 4; ++kt) {
            if (kt <= ktc) {
                __syncthreads(); stage_store((kt & 1) ? stB : stA, lds, tid); __syncthreads();
                if (kt + 2 <= ktc) stage_load((kt & 1) ? stB : stA, kcb + (size_t)(kt + 2) * 64 * 128, vcb + (size_t)(kt + 2) * 64 * 128, 128, tid);
                f32x4 sc[1][4]; bf16x8 pb[1][2];
                qk_tile<1>(lds, qf, sc, fr, fq);
                const int relb = tq - 31 - 16 * (kt * 64 + fq * 4);
                float mx = -__builtin_inff();
#pragma unroll
                for (int s = 0; s < 4; ++s)
#pragma unroll
                    for (int r = 0; r < 4; ++r) {
                        const int rel = relb - 256 * s - 16 * r;
                        const float v = sc[0][s][r] * C2 - slope2 * (float)rel;
                        sc[0][s][r] = (rel >= 0) ? v : -__builtin_inff();
                        mx = fmaxf(mx, sc[0][s][r]);
                    }
                mx = fmaxf(mx, __shfl_xor(mx, 16)); mx = fmaxf(mx, __shfl_xor(mx, 32));
                const float mn = fmaxf(m, mx);
                const float alpha = __builtin_amdgcn_exp2f(m - mn);
                m = mn; l *= alpha;
#pragma unroll
                for (int c = 0; c < 8; ++c) o[0][c] *= alpha;
#pragma unroll
                for (int i = 0; i < 16; ++i) imp[i] *= alpha;
                float ls = 0.f;
#pragma unroll
                for (int s = 0; s < 4; ++s) {
#pragma unroll
                    for (int r = 0; r < 4; ++r) { sc[0][s][r] = __builtin_amdgcn_exp2f(sc[0][s][r] - mn); ls += sc[0][s][r]; }
                    const float own = (sc[0][s][0] + sc[0][s][1]) + (sc[0][s][2] + sc[0][s][3]);
                    const float recv = __shfl(sc[0][s][3], (lane - 16) & 63);
                    imp[kt * 4 + s] += own + (fq != 0 ? recv : 0.f);
                    if (kt * 4 + s + 1 < 16) imp[kt * 4 + s + 1] += (fq != 0 ? 0.f : recv);
                }
                l += ls;
                pb[0][0] = pack8(sc[0][0], sc[0][1]); pb[0][1] = pack8(sc[0][2], sc[0][3]);
                pv_tile<1>(lds, pb, o, fr, fq);
            }
        }
    }
    {
        float lt = l; lt += __shfl_xor(lt, 16); lt += __shfl_xor(lt, 32);
        const float inv = lt > 0.f ? 1.f / lt : 0.f;
#pragma unroll
        for (int i = 0; i < 16; ++i) imp[i] *= inv;
        if (!dry) store_o_row(ocmp + rowbase * 1024 + hq * 128, o[0], inv, fq);
    }
    float sco[16];
    LAS float* scw = (LAS float*)(lds + LDS_SCO + wid * 1024) + (fr & 3) * 64;
#pragma unroll
    for (int i = 0; i < 16; ++i) {
        float tot = imp[i] + __shfl_xor(imp[i], 4);
        tot = tot + __shfl_xor(tot, 8);
        const int n = 4 * i + fq;
        const bool valid = n <= chunk;
        const bool forced = (n == 0) || (valid && n > chunk - 2);
        sco[i] = valid ? tot + (forced ? 1000.f : 0.f) : -1.f;
        scw[n] = sco[i];
    }
    asm volatile("s_waitcnt lgkmcnt(0)" ::: "memory");
    int rank[16];
#pragma unroll
    for (int i = 0; i < 16; ++i) rank[i] = 0;
    for (int j = 0; j < 16; ++j) {
        const int n2 = head * 16 + j;
        const float v2 = scw[n2];
#pragma unroll
        for (int i = 0; i < 16; ++i) {
            const int n = 4 * i + fq;
            rank[i] += ((v2 > sco[i]) || (v2 == sco[i] && n2 < n)) ? 1 : 0;
        }
    }
    unsigned mlo = 0u, mhi = 0u;
#pragma unroll
    for (int i = 0; i < 16; ++i) {
        int rk = rank[i] + __shfl_xor(rank[i], 4);
        rk = rk + __shfl_xor(rk, 8);
        const int n = 4 * i + fq;
        const bool sel = (n <= chunk) && rk < 16;
        if (i < 8) mlo |= sel ? (1u << (n & 31)) : 0u; else mhi |= sel ? (1u << (n & 31)) : 0u;
    }
    mlo |= __shfl_xor(mlo, 16); mlo |= __shfl_xor(mlo, 32); mhi |= __shfl_xor(mhi, 16); mhi |= __shfl_xor(mhi, 32);
    unsigned wlo = mlo, whi = mhi;
#pragma unroll
    for (int x = 1; x < 4; x <<= 1) { wlo |= __shfl_xor(wlo, x); whi |= __shfl_xor(whi, x); }
    wlo = __builtin_amdgcn_readfirstlane(wlo); whi = __builtin_amdgcn_readfirstlane(whi);
    LAS unsigned* wu = (LAS unsigned*)(lds + LDS_WU);
    if (lane == 0) { wu[wid * 2] = wlo; wu[wid * 2 + 1] = whi; }
    __syncthreads();
    unsigned ulo = 0u, uhi = 0u;
#pragma unroll
    for (int w = 0; w < 8; ++w) { ulo |= wu[w * 2]; uhi |= wu[w * 2 + 1]; }
    ulo = __builtin_amdgcn_readfirstlane(ulo); uhi = __builtin_amdgcn_readfirstlane(uhi);
    const unsigned long long mymask = ((unsigned long long)mhi << 32) | mlo;
    const unsigned long long wmask = ((unsigned long long)whi << 32) | wlo;
    unsigned long long rem = ((unsigned long long)uhi << 32) | ulo;
    m = -1e30f; l = 0.f;
#pragma unroll
    for (int c = 0; c < 8; ++c) o[0][c] = (f32x4){0.f, 0.f, 0.f, 0.f};
    const bf16_t* ksb = ksv + (size_t)(b * 2 + g) * 4096 * 128; const bf16_t* vsb = ksv + (size_t)4 * 2 * 4096 * 128 + (size_t)(b * 2 + g) * 4096 * 128;
#define NSA_POP(var) do { if (rem != 0ull) { var = __builtin_ctzll(rem); rem &= rem - 1; } else var = -1; } while (0)
#define NSA_SEL_COMPUTE(n) do { if (!dry && ((wmask >> (n)) & 1ull)) { \
        f32x4 sc[1][4]; bf16x8 pb[1][2]; \
        qk_tile<1>(lds, qf, sc, fr, fq); \
        const bool mysel = (mymask >> (n)) & 1ull; \
        const int relb = tq - (n) * 64 - fq * 4; \
        const float base = mysel ? -slope2 * (float)relb : -__builtin_inff(); \
        if ((n) < chunk) softmax_tile<false>(sc[0], slope2, base, relb, 0x7fffffffu, m, l, o[0], pb[0]); \
        else softmax_tile<true>(sc[0], slope2, base, relb, 0x7fffffffu, m, l, o[0], pb[0]); \
        pv_tile<1>(lds, pb, o, fr, fq); } } while (0)
    {
        int na, nb, nc, nd;
        NSA_POP(na); NSA_POP(nb);
        stage_load(stA, ksb + (size_t)(na * 64) * 128, vsb + (size_t)(na * 64) * 128, 128, tid);
        if (nb >= 0) stage_load(stB, ksb + (size_t)(nb * 64) * 128, vsb + (size_t)(nb * 64) * 128, 128, tid);
        for (;;) {
            __syncthreads(); stage_store(stA, lds, tid); __syncthreads();
            NSA_POP(nc);
            if (nc >= 0) stage_load(stA, ksb + (size_t)(nc * 64) * 128, vsb + (size_t)(nc * 64) * 128, 128, tid);
            NSA_SEL_COMPUTE(na);
            if (nb < 0) break;
            __syncthreads(); stage_store(stB, lds, tid); __syncthreads();
            NSA_POP(nd);
            if (nd >= 0) stage_load(stB, ksb + (size_t)(nd * 64) * 128, vsb + (size_t)(nd * 64) * 128, 128, tid);
            NSA_SEL_COMPUTE(nb);
            if (nc < 0) break;
            na = nc; nb = nd;
        }
    }
#undef NSA_POP
#undef NSA_SEL_COMPUTE
    {
        float lt = l; lt += __shfl_xor(lt, 16); lt += __shfl_xor(lt, 32);
        const float iv = lt > 0.f ? 1.f / lt : 0.f;
        if (!dry) store_o_row(osel + rowbase * 1024 + hq * 128, o[0], iv, fq);
    }
}

__device__ __forceinline__ void transpose_item(const float* W, int K, int N, bf16_t* WT, int item, int nblk, LAS float* scr, int lane, const float* gk, int mode, int off) {
    const int kb = item / nblk, nb = item % nblk, k0 = 64 * kb, n0 = 32 * nb;
    const int nn = n0 + (lane & 31);
    const bool nok = nn < N;
    float v[32];
#pragma unroll
    for (int i = 0; i < 32; ++i) v[i] = nok ? W[(size_t)(k0 + 2 * i + (lane >> 5)) * N + nn] : 0.f;
    if (gk) {
#pragma unroll
        for (int i = 0; i < 32; ++i) v[i] *= gk[k0 + 2 * i + (lane >> 5)];
    }
#pragma unroll
    for (int i = 0; i < 32; ++i) scr[(2 * i + (lane >> 5)) * 33 + (lane & 31)] = v[i];
    asm volatile("s_waitcnt lgkmcnt(0)" ::: "memory");
    const int c = lane & 7;
#pragma unroll
    for (int j = 0; j < 4; ++j) {
        const int n = (lane >> 3) + 8 * j; const LAS float* s = scr + (8 * c) * 33 + n;
        u32x4 ov; ov.x = cvt_pk_bf16(s[0 * 33], s[1 * 33]); ov.y = cvt_pk_bf16(s[2 * 33], s[3 * 33]); ov.z = cvt_pk_bf16(s[4 * 33], s[5 * 33]); ov.w = cvt_pk_bf16(s[6 * 33], s[7 * 33]);
        const int ng = n0 + n;
        const int row = mode ? ((ng >> 7) * 256 + (ng & 127) + off) : ng;
        *(u32x4*)(WT + (size_t)row * K + k0 + 8 * c) = ov;
    }
    asm volatile("s_waitcnt lgkmcnt(0)" ::: "memory");
}

__device__ __forceinline__ void grid_barrier(unsigned* bar, unsigned target) {
    asm volatile("s_waitcnt vmcnt(0) lgkmcnt(0)" ::: "memory");
    __syncthreads();
    if (threadIdx.x == 0) {
        __builtin_amdgcn_fence(__ATOMIC_RELEASE, "agent");
        asm volatile("s_waitcnt vmcnt(0)" ::: "memory");
        __hip_atomic_fetch_add(bar, 1u, __ATOMIC_RELAXED, __HIP_MEMORY_SCOPE_AGENT);
        while (__hip_atomic_load(bar, __ATOMIC_RELAXED, __HIP_MEMORY_SCOPE_AGENT) < target) { }
        __builtin_amdgcn_fence(__ATOMIC_ACQUIRE, "agent");
        asm volatile("s_waitcnt vmcnt(0)" ::: "memory");
    }
    __syncthreads();
}
#define GRID_SYNC() do { ++nbar; grid_barrier((unsigned*)(p.ws + WS_BAR), nbar * (unsigned)G); } while (0)
struct Params {
    const float* x; const float* norm1_g; const float* w_in;
    const float* pe_k; const float* w1_k; const float* w2_k; const float* pe_v; const float* w1_v; const float* w2_v;
    const float* gn_a; const float* gn_b; const float* w_out; const float* norm2_g; const float* w_gate; const float* w_up; const float* w_down; const float* final_g;
    float* out; unsigned char* ws;
};

__global__ void __launch_bounds__(512, 2) fwd_mega(Params p) {
    extern __shared__ __attribute__((aligned(16))) unsigned char lds_raw[];
    LAS unsigned char* lds = (LAS unsigned char*)lds_raw;
    cg::grid_group grid = cg::this_grid();
    const int tid = threadIdx.x, lane = tid & 63, wid = __builtin_amdgcn_readfirstlane(tid >> 6);
    const int G = gridDim.x, bx = blockIdx.x;
    unsigned nbar = 0;
#define ctl ((unsigned*)(p.ws + WS_CTL))
#define rsq2 ((float*)(p.ws + WS_RSQ2))
#define rsq3 ((float*)(p.ws + WS_RSQ3))
#define biasc ((float*)(p.ws + WS_BIASC))
#define biasp ((float*)(p.ws + WS_BIASP))
#define Wt_in ((bf16_t*)(p.ws + WS_WIN))
#define Wt_out ((bf16_t*)(p.ws + WS_WOUT))
#define Wt_gu ((bf16_t*)(p.ws + WS_WGU))
#define Wt_dn ((bf16_t*)(p.ws + WS_WDN))
#define Wt_c1 ((bf16_t*)(p.ws + WS_WC1))
#define W2t ((bf16_t*)(p.ws + WS_W2T))
#define craw ((bf16_t*)(p.ws + WS_CRAW))
#define hid ((bf16_t*)(p.ws + WS_HID))
#define kvc ((bf16_t*)(p.ws + WS_KVC))
#define lse ((float*)(p.ws + WS_LSE))
#define hn ((bf16_t*)(p.ws + WS_R1))
#define mixed ((bf16_t*)(p.ws + WS_R1))
#define proj ((bf16_t*)(p.ws + WS_PROJ))
#define act ((bf16_t*)(p.ws + WS_PROJ))
#define kva ((bf16_t*)(p.ws + WS_KVA))
#define kvs ((bf16_t*)(p.ws + WS_KVS))
#define ob ((bf16_t*)(p.ws + WS_OB))
#define hb ((bf16_t*)(p.ws + WS_OB))
#define oA ((bf16_t*)p.out)
    LAS int* slot = (LAS int*)(lds + LDS_SLOT);

    {
        const int gt = bx * 512 + tid;
        if (gt < T_) { rsq2[gt] = 0.f; rsq3[gt] = 0.f; }
        if (bx == 0 && tid < 16) ctl[tid] = 0u;
        for (int job = bx; job < 64; job += G) {
            const int which = job >> 5, ks = job & 31;
            const float* pe = which ? p.pe_v : p.pe_k; const float* w1 = which ? p.w1_v : p.w1_k;
            const int n = tid & 255, kh = tid >> 8, kbeg = ks * 128 + kh * 64;
            float a = 0.f;
#pragma unroll 16
            for (int k = 0; k < 64; ++k) a += pe[kbeg + k] * w1[(size_t)(kbeg + k) * 256 + n];
            biasp[(size_t)(which * 64 + ks * 2 + kh) * 256 + n] = a;
        }
        LAS float* scr = (LAS float*)(lds + wid * 8704);
        const int gw = bx * 8 + wid, NGW = G * 8;
        constexpr int I_IN = 32 * 184, I_OUT = 32 * 64, I_G = 32 * 176, I_DN = 88 * 64, I_C1 = 64 * 8, I_W2 = 4 * 4;
        constexpr int NITEMS = I_IN + I_OUT + 2 * I_G + 2 * I_C1 + 2 * I_W2;
        for (int it = gw; it < NITEMS; it += NGW) {
            int r = it;
            if (r < I_IN) { transpose_item(p.w_in, DM, PIN, Wt_in, r, 184, scr, lane, nullptr, 0, 0); continue; } r -= I_IN;
            if (r < I_OUT) { transpose_item(p.w_out, DM, DM, Wt_out, r, 64, scr, lane, nullptr, 0, 0); continue; } r -= I_OUT;
            if (r < I_G) { transpose_item(p.w_gate, DM, FF, Wt_gu, r, 176, scr, lane, p.norm2_g, 1, 0); continue; } r -= I_G;
            if (r < I_G) { transpose_item(p.w_up, DM, FF, Wt_gu, r, 176, scr, lane, p.norm2_g, 1, 128); continue; } r -= I_G;
            if (r < I_C1) { transpose_item(p.w1_k, 4096, 256, Wt_c1, r, 8, scr, lane, nullptr, 0, 0); continue; } r -= I_C1;
            if (r < I_C1) { transpose_item(p.w1_v, 4096, 256, Wt_c1 + 256 * 4096, r, 8, scr, lane, nullptr, 0, 0); continue; } r -= I_C1;
            if (r < I_W2) { transpose_item(p.w2_k, 256, 128, W2t, r, 4, scr, lane, nullptr, 0, 0); continue; } r -= I_W2;
            transpose_item(p.w2_v, 256, 128, W2t + 128 * 256, r, 4, scr, lane, nullptr, 0, 0);
        }
        for (int row = gw; row < T_; row += NGW) {
            const f32x4* xr = (const f32x4*)(p.x + (size_t)row * DM) + lane;
            f32x4 v[8]; float ss = 0.f;
#pragma unroll
            for (int j = 0; j < 8; ++j) { v[j] = xr[64 * j]; ss += (v[j][0] * v[j][0] + v[j][1] * v[j][1]) + (v[j][2] * v[j][2] + v[j][3] * v[j][3]); }
            const float r = rsqrtf(wave_sum(ss) * (1.f / DM) + EPS);
            u32x2* o8 = (u32x2*)(hn + (size_t)row * DM) + lane;
#pragma unroll
            for (int j = 0; j < 8; ++j) {
                const f32x4 gg = *((const f32x4*)p.norm1_g + lane + 64 * j);
                u32x2 w; w.x = cvt_pk_bf16(v[j][0] * r * gg[0], v[j][1] * r * gg[1]); w.y = cvt_pk_bf16(v[j][2] * r * gg[2], v[j][3] * r * gg[3]);
                o8[64 * j] = w;
            }
        }
    }
    asm volatile("s_waitcnt vmcnt(0) lgkmcnt(0)" ::: "memory");
    grid.sync();
    asm volatile("s_waitcnt vmcnt(0)" ::: "memory");

    if (bx < 2 && tid < 256) {
        float sacc = 0.f;
#pragma unroll 16
        for (int j = 0; j < 64; ++j) sacc += biasp[(size_t)(bx * 64 + j) * 256 + tid];
        biasc[bx * 256 + tid] = sacc;
    }
    {
        pg8::Gemm g{hn, Wt_in, T_, NP, DM, DM, DM}; pg8::StaticOrder S; S.init(T_, NP, G, bx);
        EpiProj E{proj, kva, kvs, craw};
        pg8::gemm_phase<EpiProj, pg8::StaticOrder>(lds, g, S, E);
        const int nunits = (T_ / 256) * (NP / 256), full = nunits / G, rem = nunits - full * G;
        if (rem > 0 && bx >= rem) {
            LAS float* scr = (LAS float*)(lds + wid * 8704);
            const int nidle = G - rem;
            for (int it = (bx - rem) * 8 + wid; it < 88 * 64; it += nidle * 8) transpose_item(p.w_down, FF, DM, Wt_dn, it, 64, scr, lane, nullptr, 0, 0);
        } else if (rem == 0) {
            LAS float* scr = (LAS float*)(lds + wid * 8704);
            for (int it = bx * 8 + wid; it < 88 * 64; it += G * 8) transpose_item(p.w_down, FF, DM, Wt_dn, it, 64, scr, lane, nullptr, 0, 0);
        }
    }
    GRID_SYNC();

    for (int job = bx; job < 16; job += G) {
        {
            const int which = job >> 3, bg = job & 7;
            bf16_t* hd = hid + (size_t)(which * 8 + bg) * 256 * 256;
            pg8::Gemm g{craw + (size_t)which * (8 * 4096 * 128), Wt_c1 + (size_t)which * 256 * 4096, 2048, 256, 4096, 2048, 4096};
            pg8::SingleOrder S{bg};
            EpiHid E{hd, biasc + which * 256};
            pg8::gemm_phase<EpiHid, pg8::SingleOrder>(lds, g, S, E);
        }
        __syncthreads();
    }
    for (;;) {
        __syncthreads();
        if (tid == 0) *slot = (int)atomicAdd(ctl + 0, 1u);
        __syncthreads();
        const int job = *slot;
        if (job >= 512 + 1536) break;
        if (job < 512) {
            const int j = job, qt = j & 15, hh = (j >> 4) & 7, b = j >> 7;
            const float slope2 = __builtin_amdgcn_exp2f(-(float)(hh + 1)) * LOG2E;
            const bf16_t* kwb = kvs + (size_t)2 * 4 * 2 * 4096 * 128 + (size_t)(b * 2 + (hh >> 2)) * 4096 * 128;
            band_job(lds, proj + (size_t)b * S_ * NQ + 1024 + hh * 128, NQ, kwb, kwb + (size_t)4 * 2 * 4096 * 128, 128,
                     qt * 256, 511, slope2, ob + (size_t)2 * T_ * 1024 + (size_t)b * S_ * 1024 + hh * 128, 1024, nullptr, 0);
        } else {
            const int j = job - 512, sub = j & 15, hh = (j >> 4) & 7, b = (j >> 7) & 3, cfg = j >> 9;
            const int dil = cfg == 0 ? 1 : (cfg == 1 ? 4 : 16);
            const int nqt = 16 / dil;
            const int r = sub / nqt, qt = sub % nqt;
            const float slope2 = __builtin_amdgcn_exp2f(-0.5f * (float)(2 * hh + 1)) * (float)dil * LOG2E;
            const bf16_t* kab = kva + ((size_t)(b * 8 + hh) * 4096 + r) * 128;
            band_job(lds, proj + (size_t)(b * S_ + r) * NQ + hh * 128, (long)dil * NQ, kab, kab + (size_t)4 * 8 * 4096 * 128, (long)dil * 128, qt * 256, 128, slope2,
                     oA + (size_t)cfg * T_ * 1024 + (size_t)(b * S_ + r) * 1024 + hh * 128, (long)dil * 1024,
                     lse + (size_t)cfg * T_ * 8 + (size_t)(b * S_ + r) * 8 + hh, (long)dil * 8);
        }
    }
    GRID_SYNC();

    for (int grp = bx; grp < 256; grp += G) {
        const int which = grp >> 7, bg = (grp >> 4) & 7, r0 = (grp & 15) * 16;
        const u32x4* wsrc = (const u32x4*)(W2t + (size_t)which * 128 * 256);
        const u32x4* hsrc = (const u32x4*)(hid + ((size_t)(which * 8 + bg) * 256 + r0) * 256);
        __syncthreads();
        for (int i = tid; i < 4096; i += 512) *(LAS u32x4*)(lds + i * 16) = wsrc[i];
        *(LAS u32x4*)(lds + 65536 + tid * 16) = hsrc[tid];
        __syncthreads();
        const int d = tid & 127, rq = tid >> 7;
        const LAS u32x4* wl = (const LAS u32x4*)(lds + d * 512);
        float acc2[4] = {0.f, 0.f, 0.f, 0.f};
        for (int jb = 0; jb < 32; ++jb) {
            const u32x4 wv = wl[(jb + d) & 31];
            const int jc = (jb + d) & 31;
#pragma unroll
            for (int r = 0; r < 4; ++r) {
                const u32x4 hv = *(const LAS u32x4*)(lds + 65536 + (rq * 4 + r) * 512 + jc * 16);
#pragma unroll
                for (int e = 0; e < 4; ++e) acc2[r] += bf_lo(wv[e]) * bf_lo(hv[e]) + bf_hi(wv[e]) * bf_hi(hv[e]);
            }
        }
        bf16_t* dstb = kvc + ((size_t)(which * 8 + bg) * 256 + r0) * 128;
#pragma unroll
        for (int r = 0; r < 4; ++r) {
            const int c = r0 + rq * 4 + r;
            const unsigned w16 = cvt_pk_bf16(c == 255 ? 0.f : acc2[r], 0.f);
            dstb[(size_t)(rq * 4 + r) * 128 + d] = (bf16_t)(w16 & 0xffffu);
        }
    }
    GRID_SYNC();

    for (;;) {
        __syncthreads();
        if (tid == 0) *slot = (int)atomicAdd(ctl + 1, 1u);
        __syncthreads();
        const int job = *slot;
        if (job >= 1024) break;
        const int chunk = 63 - (job >> 4), bg = job & 7, half = (job >> 3) & 1;
        nsa_job(lds, proj, kvs, kvc, kvc + (size_t)8 * 256 * 128, ob, ob + (size_t)T_ * 1024, bg >> 1, bg & 1, chunk, half);
    }
    GRID_SYNC();

    {
        const int gw = bx * 8 + wid, NGW = G * 8;
        for (int row = gw; row < T_; row += NGW) {
            u32x4 xa[3][2], xb[3][2];
#pragma unroll
            for (int i = 0; i < 3; ++i)
#pragma unroll
                for (int q = 0; q < 2; ++q) {
                    xa[i][q] = *(const u32x4*)(oA + (size_t)(i * T_ + row) * 1024 + q * 512 + lane * 8);
                    xb[i][q] = *(const u32x4*)(ob + (size_t)(i * T_ + row) * 1024 + q * 512 + lane * 8);
                }
            float o[16]; float ss = 0.f;
#pragma unroll
            for (int q = 0; q < 2; ++q) {
                const int h = q * 4 + (lane >> 4);
                const float l0 = lse[(size_t)row * 8 + h], l1 = lse[(size_t)(T_ + row) * 8 + h], l2 = lse[(size_t)(2 * T_ + row) * 8 + h];
                const float mx = fmaxf(l0, fmaxf(l1, l2));
                float w0 = __expf(l0 - mx), w1 = __expf(l1 - mx), w2 = __expf(l2 - mx);
                const float wi = 1.f / (w0 + w1 + w2); w0 *= wi; w1 *= wi; w2 *= wi;
#pragma unroll
                for (int e = 0; e < 4; ++e) {
                    o[q * 8 + 2 * e] = w0 * bf_lo(xa[0][q][e]) + w1 * bf_lo(xa[1][q][e]) + w2 * bf_lo(xa[2][q][e]);
                    o[q * 8 + 2 * e + 1] = w0 * bf_hi(xa[0][q][e]) + w1 * bf_hi(xa[1][q][e]) + w2 * bf_hi(xa[2][q][e]);
                }
            }
#pragma unroll
            for (int e = 0; e < 16; ++e) ss += o[e] * o[e];
            float r = rsqrtf(wave_sum(ss) * (1.f / 1024.f) + EPS);
#pragma unroll
            for (int q = 0; q < 2; ++q) {
                const f32x4 ga = *(const f32x4*)(p.gn_a + q * 512 + lane * 8), gb = *(const f32x4*)(p.gn_a + q * 512 + lane * 8 + 4);
                u32x4 w;
                w.x = cvt_pk_bf16(o[q * 8 + 0] * r * ga[0], o[q * 8 + 1] * r * ga[1]); w.y = cvt_pk_bf16(o[q * 8 + 2] * r * ga[2], o[q * 8 + 3] * r * ga[3]);
                w.z = cvt_pk_bf16(o[q * 8 + 4] * r * gb[0], o[q * 8 + 5] * r * gb[1]); w.w = cvt_pk_bf16(o[q * 8 + 6] * r * gb[2], o[q * 8 + 7] * r * gb[3]);
                *(u32x4*)(mixed + (size_t)row * DM + q * 512 + lane * 8) = w;
            }
            ss = 0.f;
#pragma unroll
            for (int q = 0; q < 2; ++q) {
                const int h = q * 4 + (lane >> 4);
                const bf16_t* gp = proj + (size_t)row * NQ + 2048 + h * 3;
                const float g0 = 1.f / (1.f + __expf(-bf1(gp[0]))), g1 = 1.f / (1.f + __expf(-bf1(gp[1]))), g2 = 1.f / (1.f + __expf(-bf1(gp[2])));
#pragma unroll
                for (int e = 0; e < 4; ++e) {
                    o[q * 8 + 2 * e] = g0 * bf_lo(xb[0][q][e]) + g1 * bf_lo(xb[1][q][e]) + g2 * bf_lo(xb[2][q][e]);
                    o[q * 8 + 2 * e + 1] = g0 * bf_hi(xb[0][q][e]) + g1 * bf_hi(xb[1][q][e]) + g2 * bf_hi(xb[2][q][e]);
                }
            }
#pragma unroll
            for (int e = 0; e < 16; ++e) ss += o[e] * o[e];
            r = rsqrtf(wave_sum(ss) * (1.f / 1024.f) + EPS);
#pragma unroll
            for (int q = 0; q < 2; ++q) {
                const f32x4 ga = *(const f32x4*)(p.gn_b + q * 512 + lane * 8), gb = *(const f32x4*)(p.gn_b + q * 512 + lane * 8 + 4);
                u32x4 w;
                w.x = cvt_pk_bf16(o[q * 8 + 0] * r * ga[0], o[q * 8 + 1] * r * ga[1]); w.y = cvt_pk_bf16(o[q * 8 + 2] * r * ga[2], o[q * 8 + 3] * r * ga[3]);
                w.z = cvt_pk_bf16(o[q * 8 + 4] * r * gb[0], o[q * 8 + 5] * r * gb[1]); w.w = cvt_pk_bf16(o[q * 8 + 6] * r * gb[2], o[q * 8 + 7] * r * gb[3]);
                *(u32x4*)(mixed + (size_t)row * DM + 1024 + q * 512 + lane * 8) = w;
            }
        }
    }
    GRID_SYNC();

    {
        pg8::Gemm g{mixed, Wt_out, T_, DM, DM, DM, DM}; pg8::StaticOrder S; S.init(T_, DM, G, bx);
        EpiWout E{p.x, hb, rsq2};
        pg8::gemm_phase<EpiWout, pg8::StaticOrder>(lds, g, S, E);
    }
    GRID_SYNC();

    {
        pg8::Gemm g{hb, Wt_gu, T_, 2 * FF, DM, DM, DM}; pg8::StaticOrder S; S.init(T_, 2 * FF, G, bx);
        EpiSwiglu E{act, rsq2};
        pg8::gemm_phase<EpiSwiglu, pg8::StaticOrder>(lds, g, S, E);
    }
    GRID_SYNC();

    {
        pg8::Gemm g{act, Wt_dn, T_, DM, FF, FF, FF}; pg8::StaticOrder S; S.init(T_, DM, G, bx);
        EpiDown E{hb, mixed, rsq3};
        pg8::gemm_phase<EpiDown, pg8::StaticOrder>(lds, g, S, E);
    }
    GRID_SYNC();

    {
        const int gw = bx * 8 + wid, NGW = G * 8;
        for (int row0 = gw; row0 < T_; row0 += 4 * NGW) {
            u32x4 yv[4][4];
#pragma unroll
            for (int i = 0; i < 4; ++i) {
                const int row = row0 + i * NGW;
                if (row < T_) {
#pragma unroll
                    for (int q = 0; q < 4; ++q) yv[i][q] = *(const u32x4*)(mixed + (size_t)row * DM + q * 512 + lane * 8);
                }
            }
#pragma unroll
            for (int i = 0; i < 4; ++i) {
                const int row = row0 + i * NGW;
                if (row < T_) {
                    const float r = rsqrtf(rsq3[row] * (1.f / DM) + EPS);
#pragma unroll
                    for (int q = 0; q < 4; ++q) {
                        const f32x4 ga = *(const f32x4*)(p.final_g + q * 512 + lane * 8), gb = *(const f32x4*)(p.final_g + q * 512 + lane * 8 + 4);
                        const u32x4 w = yv[i][q];
                        f32x4 o0, o1;
                        o0[0] = bf_lo(w.x) * r * ga[0]; o0[1] = bf_hi(w.x) * r * ga[1]; o0[2] = bf_lo(w.y) * r * ga[2]; o0[3] = bf_hi(w.y) * r * ga[3];
                        o1[0] = bf_lo(w.z) * r * gb[0]; o1[1] = bf_hi(w.z) * r * gb[1]; o1[2] = bf_lo(w.w) * r * gb[2]; o1[3] = bf_hi(w.w) * r * gb[3];
                        float* dst = p.out + (size_t)row * DM + q * 512 + lane * 8;
                        *(f32x4*)dst = o0; *(f32x4*)(dst + 4) = o1;
                    }
                }
            }
        }
    }
}

extern "C" void kernel_launch(void* const* d_in, const int* in_sizes, int n_in, void* d_out, int out_size, void* d_ws, size_t ws_size, hipStream_t stream) {
    static int grid_blocks = 0;
    if (grid_blocks == 0) {
        if (n_in != 17 || out_size != T_ * DM || ws_size < WS_END) { fprintf(stderr, "kernel_launch: unexpected shapes / workspace (n_in %d out %d ws %zu need %zu)\n", n_in, out_size, ws_size, (size_t)WS_END); grid_blocks = -1; return; }
        int dev = 0, cus = 0, per_cu = 0;
        hipGetDevice(&dev);
        hipDeviceGetAttribute(&cus, hipDeviceAttributeMultiprocessorCount, dev);
        if (hipFuncSetAttribute((const void*)fwd_mega, hipFuncAttributeMaxDynamicSharedMemorySize, LDS_BYTES) != hipSuccess) { fprintf(stderr, "kernel_launch: hipFuncSetAttribute failed\n"); grid_blocks = -1; return; }
        if (hipOccupancyMaxActiveBlocksPerMultiprocessor(&per_cu, (const void*)fwd_mega, 512, LDS_BYTES) != hipSuccess || per_cu < 1) { fprintf(stderr, "kernel_launch: occupancy query failed (%d)\n", per_cu); per_cu = 1; (void)hipGetLastError(); }
        if (per_cu > 1) per_cu = 1;
        grid_blocks = cus * per_cu;
    }
    if (grid_blocks < 0) return;
    Params p{};
    p.x = (const float*)d_in[0]; p.norm1_g = (const float*)d_in[1]; p.w_in = (const float*)d_in[2];
    p.pe_k = (const float*)d_in[3]; p.w1_k = (const float*)d_in[4]; p.w2_k = (const float*)d_in[5];
    p.pe_v = (const float*)d_in[6]; p.w1_v = (const float*)d_in[7]; p.w2_v = (const float*)d_in[8];
    p.gn_a = (const float*)d_in[9]; p.gn_b = (const float*)d_in[10]; p.w_out = (const float*)d_in[11]; p.norm2_g = (const float*)d_in[12];
    p.w_gate = (const float*)d_in[13]; p.w_up = (const float*)d_in[14]; p.w_down = (const float*)d_in[15]; p.final_g = (const float*)d_in[16];
    p.out = (float*)d_out; p.ws = (unsigned char*)d_ws;
    if (hipMemsetAsync((char*)d_ws + WS_BAR, 0, 256, stream) != hipSuccess) { fprintf(stderr, "kernel_launch: memset failed\n"); return; }
    void* args[] = {&p};
    hipError_t e = hipLaunchCooperativeKernel((const void*)fwd_mega, dim3(grid_blocks), dim3(512), args, LDS_BYTES, stream);
    if (e != hipSuccess) fprintf(stderr, "cooperative launch failed: %s (grid %d)\n", hipGetErrorString(e), grid_blocks);
}
```

```cpp
#include <hip/hip_runtime.h>
#include <hip/hip_cooperative_groups.h>
#include <cstdio>
#include <cstdint>
namespace cg = cooperative_groups;

#define LAS __attribute__((address_space(3)))
typedef unsigned short bf16_t;
typedef short bf16x8 __attribute__((ext_vector_type(8)));
typedef float f32x4 __attribute__((ext_vector_type(4)));
typedef unsigned u32x4 __attribute__((ext_vector_type(4)));
typedef unsigned u32x2 __attribute__((ext_vector_type(2)));

constexpr int T_ = 16384, S_ = 4096, DM = 2048, PIN = 5656, NP = 5888, FF = 5632;
constexpr float EPS = 1e-6f;
constexpr float LOG2E = 1.4426950408889634f, LN2 = 0.6931471805599453f;
constexpr float C2 = 0.08838834764831845f * 1.4426950408889634f;

constexpr size_t al256(size_t x) { return (x + 255) & ~(size_t)255; }
constexpr size_t WS_CTL = 0;
constexpr size_t WS_BAR = 2048;
constexpr size_t WS_RSQ2 = 4096;
constexpr size_t WS_RSQ3 = WS_RSQ2 + (size_t)T_ * 4;
constexpr size_t WS_BIASC = WS_RSQ3 + (size_t)T_ * 4;
constexpr size_t WS_BIASP = al256(WS_BIASC + 2048);
constexpr size_t WS_WIN = al256(WS_BIASP + 131072);
constexpr size_t WS_WOUT = WS_WIN + (size_t)NP * DM * 2;
constexpr size_t WS_WGU = WS_WOUT + (size_t)DM * DM * 2;
constexpr size_t WS_WDN = WS_WGU + (size_t)2 * FF * DM * 2;
constexpr size_t WS_WC1 = WS_WDN + (size_t)DM * FF * 2;
constexpr size_t WS_W2T = WS_WC1 + (size_t)2 * 256 * 4096 * 2;
constexpr size_t WS_HID = WS_W2T + (size_t)2 * 128 * 256 * 2;
constexpr size_t WS_KVC = WS_HID + (size_t)2 * 8 * 256 * 256 * 2;
constexpr size_t WS_LSE = WS_KVC + (size_t)2 * 8 * 256 * 128 * 2;
constexpr size_t WS_R1 = WS_LSE + (size_t)3 * T_ * 8 * 4;
constexpr int NQ = 2304;
constexpr size_t WS_PROJ = WS_R1 + (size_t)T_ * DM * 2;
constexpr size_t WS_KVA = WS_PROJ + (size_t)T_ * NQ * 2;
constexpr size_t WS_KVS = WS_KVA + (size_t)2 * 4 * 8 * 4096 * 128 * 2;
constexpr size_t WS_CRAW = WS_KVS + (size_t)4 * 4 * 2 * 4096 * 128 * 2;
constexpr size_t WS_OB = WS_CRAW + (size_t)2 * 8 * 4096 * 128 * 2 + 16384;
constexpr size_t WS_END = WS_OB + (size_t)3 * T_ * 1024 * 2;
static_assert(WS_OB - WS_PROJ >= (size_t)T_ * FF * 2, "act overlay");
static_assert(WS_END <= (size_t)536870912, "workspace");

constexpr int LDS_BYTES = 131072 + 1024;
constexpr int LDS_SLOT = 131072;

typedef __bf16 bf16v2 __attribute__((ext_vector_type(2)));
typedef float f32x2 __attribute__((ext_vector_type(2)));
__device__ __forceinline__ unsigned cvt_pk_bf16(float lo, float hi) { f32x2 v = {lo, hi}; bf16v2 b = __builtin_convertvector(v, bf16v2); return __builtin_bit_cast(unsigned, b); }
__device__ __forceinline__ float bf_lo(unsigned w) { return __uint_as_float(w << 16); }
__device__ __forceinline__ float bf_hi(unsigned w) { return __uint_as_float(w & 0xffff0000u); }
__device__ __forceinline__ float bf1(bf16_t b) { return __uint_as_float(((unsigned)b) << 16); }
__device__ __forceinline__ float wave_sum(float v) {
#pragma unroll
    for (int o = 1; o < 64; o <<= 1) v += __shfl_xor(v, o);
    return v;
}

namespace pg8 {
constexpr int BM = 256, BK = 64, HALF = 128, HTB = HALF * BK * 2, STAGE_BYTES = 8 * HTB, NXCD = 8, WGM = 4;
__host__ __device__ __forceinline__ int lds_byte(int r, int c) { const int st = (r >> 4) * 2 + (c >> 5), rr = r & 15, cc = c & 31, ob = rr * 64 + cc * 2; return st * 1024 + (ob ^ (((ob >> 9) & 1) << 5)); }
__host__ __device__ __forceinline__ void stage_rc(int b, int& R, int& C) { const int st = b / 1024, sb = b % 1024, swz = sb ^ (((sb >> 9) & 1) << 5); R = (st >> 1) * 16 + swz / 64; C = (st & 1) * 32 + (swz % 64) / 2; }
__host__ __device__ __forceinline__ int perm32(int rho) { const int n = rho >> 4, i = rho & 15; return 8 * (i >> 2) + 4 * n + (i & 3); }
struct Unit { int pm, pn; };
struct Gemm { const bf16_t* A; const bf16_t* Bt; int M, N, K, lda, ldb; };
struct StaticOrder {
    int nM, nN, nwg, G, c;
    __device__ void init(int M, int N, int G_, int c_) { nM = M / BM; nN = N / BM; nwg = nM * nN; G = G_; c = c_; }
    __device__ bool next(int i, Unit& u) const {
        const long L = (long)i * G + c; if (L >= nwg) return false;
        int wgid = (int)L; { const int q = nwg / NXCD, r = nwg % NXCD, xcd = wgid % NXCD, off = wgid / NXCD; wgid = (xcd < r ? xcd * (q + 1) : r * (q + 1) + (xcd - r) * q) + off; }
        const int nig = WGM * nN, gid = wgid / nig, fm = gid * WGM, gsz = (nM - fm) < WGM ? (nM - fm) : WGM;
        u.pm = fm + ((wgid % nig) % gsz); u.pn = (wgid % nig) / gsz; return true;
    }
};
struct SingleOrder {
    int pm;
    __device__ bool next(int i, Unit& u) const { if (i != 0) return false; u.pm = pm; u.pn = 0; return true; }
};

template <class Epi, class Sched>
__device__ __forceinline__ void gemm_phase(LAS unsigned char* lds, const Gemm g, const Sched& S, const Epi& E) {
    int tid_ = threadIdx.x; asm volatile("" : "+v"(tid_));
    const int tid = tid_, wid = __builtin_amdgcn_readfirstlane(tid >> 6), lane = tid & 63, wr = wid >> 2, wc = wid & 3, fr = lane & 15, fq = lane >> 4;
    const int K = g.K, nt = K / BK;
    unsigned voffA[2], voffB[2];
#pragma unroll
    for (int i = 0; i < 2; ++i) { int R, C; stage_rc(tid * 16 + i * 8192, R, C);
        const int Rb = (R & ~31) + perm32(R & 31);
        voffA[i] = (unsigned)(R * g.lda + C) * 2u; voffB[i] = (unsigned)(Rb * g.ldb + C) * 2u; }
    const size_t kstep = (size_t)(BK * 2);
    const size_t hstepA = (size_t)HALF * g.lda * 2, hstepB = (size_t)HALF * g.ldb * 2;
    const size_t tstepA = 2 * hstepA, tstepB = 2 * hstepB;
    const unsigned ldsw = (unsigned)wid * 1024u;
    const int aoff = lds_byte(wr * 64 + fr, fq * 8), boff = lds_byte(wc * 32 + fr, fq * 8);
#define PG8_SA(b, h) (((b) * 2 + (h)) * HTB)
#define PG8_SB(b, h) ((4 + (b) * 2 + (h)) * HTB)
#define PG8_STAGE(bufoff, gbase, voff) do { _Pragma("unroll") for (int _i = 0; _i < 2; ++_i) \
        __builtin_amdgcn_global_load_lds((const unsigned*)((const char*)(gbase) + (voff)[_i]), (LAS unsigned*)(lds + (bufoff) + ldsw + _i * 8192), 16, 0, 0); } while (0)
#define PG8_LDA(dst, b, h) do { _Pragma("unroll") for (int m = 0; m < 4; ++m) _Pragma("unroll") for (int k = 0; k < 2; ++k) dst[m][k] = *(const LAS bf16x8*)(lds + PG8_SA(b, h) + aoff + m * 2048 + k * 1024); } while (0)
#define PG8_LDB(dst, b, h) do { _Pragma("unroll") for (int n = 0; n < 2; ++n) _Pragma("unroll") for (int k = 0; k < 2; ++k) dst[n][k] = *(const LAS bf16x8*)(lds + PG8_SB(b, h) + boff + n * 2048 + k * 1024); } while (0)
#define PG8_MMA(ai, bj, At, Bt) do { __builtin_amdgcn_s_setprio(1); _Pragma("unroll") for (int m = 0; m < 4; ++m) _Pragma("unroll") for (int n = 0; n < 2; ++n) _Pragma("unroll") for (int k = 0; k < 2; ++k) \
        acc[ai][bj][m][n] = __builtin_amdgcn_mfma_f32_16x16x32_bf16(Bt[n][k], At[m][k], acc[ai][bj][m][n], 0, 0, 0); __builtin_amdgcn_s_setprio(0); } while (0)
#define PG8_WAIT_V(n) asm volatile("s_waitcnt vmcnt(" #n ")" ::: "memory")
#define PG8_WAIT_L(n) asm volatile("s_waitcnt lgkmcnt(" #n ")" ::: "memory")
#define PG8_BAR __builtin_amdgcn_s_barrier()
#define PG8_SCHED __builtin_amdgcn_sched_barrier(0)
    Unit cur, nxt; int ui = 0;
    if (!S.next(0, cur)) return;
    f32x4 acc[2][2][4][2];
#pragma unroll
    for (int a = 0; a < 2; ++a)
#pragma unroll
        for (int b = 0; b < 2; ++b)
#pragma unroll
            for (int m = 0; m < 4; ++m)
#pragma unroll
                for (int n = 0; n < 2; ++n) acc[a][b][m][n] = (f32x4){0.f, 0.f, 0.f, 0.f};
    bf16x8 At[4][2], B0[2][2], B1[2][2];
    const char* cA = (const char*)g.A + (size_t)cur.pm * tstepA; const char* cB = (const char*)g.Bt + (size_t)cur.pn * tstepB;
    PG8_STAGE(PG8_SB(0, 0), cB, voffB); PG8_STAGE(PG8_SB(0, 1), cB + hstepB, voffB); PG8_STAGE(PG8_SA(0, 0), cA, voffA); PG8_STAGE(PG8_SA(0, 1), cA + hstepA, voffA);
    if (wr == 1) PG8_BAR;
    PG8_WAIT_V(2); PG8_BAR;
    PG8_STAGE(PG8_SB(1, 0), cB + kstep, voffB); PG8_STAGE(PG8_SA(1, 0), cA + kstep, voffA); PG8_STAGE(PG8_SB(1, 1), cB + hstepB + kstep, voffB);
    PG8_WAIT_V(6); PG8_BAR;
    for (;;) {
        const bool has_next = S.next(ui + 1, nxt);
        const char* nA = has_next ? (const char*)g.A + (size_t)nxt.pm * tstepA : cA; const char* nB = has_next ? (const char*)g.Bt + (size_t)nxt.pn * tstepB : cB;
        for (int t = 0; t < nt; t += 2) {
            const bool last = (t == nt - 2);
            const char* a1 = cA + (size_t)(t + 1) * kstep;
            const char* a2 = last ? nA : cA + (size_t)(t + 2) * kstep; const char* b2 = last ? nB : cB + (size_t)(t + 2) * kstep;
            const char* a3 = a2 + kstep; const char* b3 = b2 + kstep;
            PG8_LDB(B0, 0, 0); PG8_LDB(B1, 0, 1); PG8_SCHED; PG8_LDA(At, 0, 0); PG8_STAGE(PG8_SA(1, 1), a1 + hstepA, voffA);
            PG8_WAIT_V(8); PG8_WAIT_L(0); PG8_BAR; PG8_MMA(0, 0, At, B0); PG8_MMA(0, 1, At, B1); PG8_BAR; PG8_SCHED;
            PG8_LDA(At, 0, 1); PG8_STAGE(PG8_SB(0, 0), b2, voffB); PG8_STAGE(PG8_SB(0, 1), b2 + hstepB, voffB); PG8_STAGE(PG8_SA(0, 0), a2, voffA);
            PG8_WAIT_V(8); PG8_WAIT_L(0); PG8_BAR; PG8_MMA(1, 0, At, B0); PG8_MMA(1, 1, At, B1); PG8_BAR; PG8_SCHED;
            PG8_LDB(B0, 1, 0); PG8_LDB(B1, 1, 1); PG8_SCHED; PG8_LDA(At, 1, 0); PG8_STAGE(PG8_SA(0, 1), a2 + hstepA, voffA);
            PG8_WAIT_V(8); PG8_WAIT_L(0); PG8_BAR; PG8_MMA(0, 0, At, B0); PG8_MMA(0, 1, At, B1); PG8_BAR; PG8_SCHED;
            PG8_LDA(At, 1, 1); PG8_STAGE(PG8_SB(1, 0), b3, voffB); PG8_STAGE(PG8_SB(1, 1), b3 + hstepB, voffB); PG8_STAGE(PG8_SA(1, 0), a3, voffA);
            PG8_WAIT_V(8); PG8_WAIT_L(0); PG8_BAR; PG8_MMA(1, 0, At, B0); PG8_MMA(1, 1, At, B1); PG8_BAR; PG8_SCHED;
        }
        if (wr == 0) PG8_BAR;
        E(acc, cur, wr, wc, fr, fq);
        if (!has_next) break;
#pragma unroll
        for (int a = 0; a < 2; ++a)
#pragma unroll
            for (int b = 0; b < 2; ++b)
#pragma unroll
                for (int m = 0; m < 4; ++m)
#pragma unroll
                    for (int n = 0; n < 2; ++n) acc[a][b][m][n] = (f32x4){0.f, 0.f, 0.f, 0.f};
        cur = nxt; cA = nA; cB = nB; ++ui;
        if (wr == 1) PG8_BAR;
    }
    PG8_WAIT_V(0);
    PG8_BAR;
#undef PG8_SA
#undef PG8_SB
#undef PG8_STAGE
#undef PG8_LDA
#undef PG8_LDB
#undef PG8_MMA
#undef PG8_WAIT_V
#undef PG8_WAIT_L
#undef PG8_BAR
#undef PG8_SCHED
}
}

typedef f32x4 Acc[2][2][4][2];

struct EpiProj {
    bf16_t* projq; bf16_t* kva; bf16_t* kvs; bf16_t* craw;
    __device__ __forceinline__ void operator()(const Acc& acc, const pg8::Unit& u, int wr, int wc, int fr, int fq) const {
        const int pn = u.pn;
        bf16_t* base; long SJ, SB, ST;
        if (pn < 4)       { base = projq + pn * 256;                                   SJ = 128; SB = (long)4096 * NQ; ST = NQ; }
        else if (pn < 8)  { base = kva + (size_t)((pn - 4) * 2) * 4096 * 128;          SJ = (long)4096 * 128; SB = (long)8 * 4096 * 128; ST = 128; }
        else if (pn < 12) { base = kva + (size_t)4 * 8 * 4096 * 128 + (size_t)((pn - 8) * 2) * 4096 * 128; SJ = (long)4096 * 128; SB = (long)8 * 4096 * 128; ST = 128; }
        else if (pn < 16) { base = projq + 1024 + (pn - 12) * 256;                     SJ = 128; SB = (long)4096 * NQ; ST = NQ; }
        else if (pn < 18) { base = craw + (size_t)(pn - 16) * (8 * 4096 * 128);        SJ = (long)4096 * 128; SB = (long)2 * 4096 * 128; ST = 128; }
        else if (pn < 22) { base = kvs + (size_t)(pn - 18) * (4 * 2 * 4096 * 128);     SJ = (long)4096 * 128; SB = (long)2 * 4096 * 128; ST = 128; }
        else              { base = projq + 2048;                                       SJ = 128; SB = (long)4096 * NQ; ST = NQ; }
        const int row0 = u.pm * 256 + wr * 64 + fr;
        bf16_t* lanep = base + (long)(row0 >> 12) * SB + (long)(row0 & 4095) * ST + wc * 32 + fq * 8;
#pragma unroll
        for (int ai = 0; ai < 2; ++ai)
#pragma unroll
            for (int m = 0; m < 4; ++m) {
                bf16_t* rowp = lanep + (long)(ai * 128 + m * 16) * ST;
#pragma unroll
                for (int bj = 0; bj < 2; ++bj) {
                    const f32x4 v0 = acc[ai][bj][m][0], v1 = acc[ai][bj][m][1];
                    u32x4 w; w.x = cvt_pk_bf16(v0[0], v0[1]); w.y = cvt_pk_bf16(v0[2], v0[3]); w.z = cvt_pk_bf16(v1[0], v1[1]); w.w = cvt_pk_bf16(v1[2], v1[3]);
                    *(u32x4*)(rowp + bj * SJ) = w;
                }
            }
    }
};
struct EpiHid {
    bf16_t* hid; const float* bias;
    __device__ __forceinline__ void operator()(const Acc& acc, const pg8::Unit& u, int wr, int wc, int fr, int fq) const {
#pragma unroll
        for (int bj = 0; bj < 2; ++bj)
#pragma unroll
            for (int n = 0; n < 2; ++n) {
                const int col = bj * 128 + wc * 32 + fq * 8 + n * 4;
                const f32x4 bv = *(const f32x4*)(bias + col);
#pragma unroll
                for (int ai = 0; ai < 2; ++ai)
#pragma unroll
                    for (int m = 0; m < 4; ++m) {
                        const int row = ai * 128 + wr * 64 + m * 16 + fr;
                        f32x4 v = acc[ai][bj][m][n] + bv;
#pragma unroll
                        for (int j = 0; j < 4; ++j) v[j] = v[j] * __builtin_amdgcn_rcpf(1.f + __expf(-v[j]));
                        u32x2 w; w.x = cvt_pk_bf16(v[0], v[1]); w.y = cvt_pk_bf16(v[2], v[3]);
                        *(u32x2*)(hid + (size_t)row * 256 + col) = w;
                    }
            }
    }
};
struct EpiWout {
    const float* x; bf16_t* hb; float* rsq;
    __device__ __forceinline__ void operator()(const Acc& acc, const pg8::Unit& u, int wr, int wc, int fr, int fq) const {
#pragma unroll
        for (int ai = 0; ai < 2; ++ai)
#pragma unroll
            for (int m = 0; m < 4; ++m) {
                const int row = u.pm * 256 + ai * 128 + wr * 64 + m * 16 + fr;
                float ss = 0.f;
#pragma unroll
                for (int bj = 0; bj < 2; ++bj) {
                    const size_t off = (size_t)row * DM + u.pn * 256 + bj * 128 + wc * 32 + fq * 8;
                    const f32x4 h0 = *(const f32x4*)(x + off) + acc[ai][bj][m][0], h1 = *(const f32x4*)(x + off + 4) + acc[ai][bj][m][1];
                    u32x4 w; w.x = cvt_pk_bf16(h0[0], h0[1]); w.y = cvt_pk_bf16(h0[2], h0[3]); w.z = cvt_pk_bf16(h1[0], h1[1]); w.w = cvt_pk_bf16(h1[2], h1[3]);
                    *(u32x4*)(hb + off) = w;
                    ss += (h0[0] * h0[0] + h0[1] * h0[1]) + (h0[2] * h0[2] + h0[3] * h0[3]) + (h1[0] * h1[0] + h1[1] * h1[1]) + (h1[2] * h1[2] + h1[3] * h1[3]);
                }
                ss += __shfl_xor(ss, 16); ss += __shfl_xor(ss, 32);
                if (fq == 0) atomicAdd(rsq + row, ss);
            }
    }
};
struct EpiSwiglu {
    bf16_t* act; const float* rsq;
    __device__ __forceinline__ void operator()(const Acc& acc, const pg8::Unit& u, int wr, int wc, int fr, int fq) const {
#pragma unroll
        for (int ai = 0; ai < 2; ++ai)
#pragma unroll
            for (int m = 0; m < 4; ++m) {
                const int row = u.pm * 256 + ai * 128 + wr * 64 + m * 16 + fr;
                const float r = rsqrtf(rsq[row] * (1.f / DM) + EPS);
                u32x4 w;
#pragma unroll
                for (int n = 0; n < 2; ++n) {
                    const f32x4 g = acc[ai][0][m][n] * r, up = acc[ai][1][m][n] * r;
                    f32x4 a;
#pragma unroll
                    for (int j = 0; j < 4; ++j) a[j] = g[j] * __builtin_amdgcn_rcpf(1.f + __expf(-g[j])) * up[j];
                    w[2 * n] = cvt_pk_bf16(a[0], a[1]); w[2 * n + 1] = cvt_pk_bf16(a[2], a[3]);
                }
                *(u32x4*)(act + (size_t)row * FF + u.pn * 128 + wc * 32 + fq * 8) = w;
            }
    }
};
struct EpiDown {
    const bf16_t* hb; bf16_t* out; float* rsq;
    __device__ __forceinline__ void operator()(const Acc& acc, const pg8::Unit& u, int wr, int wc, int fr, int fq) const {
#pragma unroll
        for (int ai = 0; ai < 2; ++ai)
#pragma unroll
            for (int m = 0; m < 4; ++m) {
                const int row = u.pm * 256 + ai * 128 + wr * 64 + m * 16 + fr;
                float ss = 0.f;
#pragma unroll
                for (int bj = 0; bj < 2; ++bj) {
                    const size_t off = (size_t)row * DM + u.pn * 256 + bj * 128 + wc * 32 + fq * 8;
                    const u32x4 hw = *(const u32x4*)(hb + off);
                    f32x4 y0 = acc[ai][bj][m][0], y1 = acc[ai][bj][m][1];
                    y0[0] += bf_lo(hw.x); y0[1] += bf_hi(hw.x); y0[2] += bf_lo(hw.y); y0[3] += bf_hi(hw.y);
                    y1[0] += bf_lo(hw.z); y1[1] += bf_hi(hw.z); y1[2] += bf_lo(hw.w); y1[3] += bf_hi(hw.w);
                    { u32x4 w; w.x = cvt_pk_bf16(y0[0], y0[1]); w.y = cvt_pk_bf16(y0[2], y0[3]); w.z = cvt_pk_bf16(y1[0], y1[1]); w.w = cvt_pk_bf16(y1[2], y1[3]); *(u32x4*)(out + off) = w; }
                    ss += (y0[0] * y0[0] + y0[1] * y0[1]) + (y0[2] * y0[2] + y0[3] * y0[3]) + (y1[0] * y1[0] + y1[1] * y1[1]) + (y1[2] * y1[2] + y1[3] * y1[3]);
                }
                ss += __shfl_xor(ss, 16); ss += __shfl_xor(ss, 32);
                if (fq == 0) atomicAdd(rsq + row, ss);
            }
    }
};

constexpr int KP = 136, VPN = 144;
constexpr int LDS_K = 0, LDS_V = 64 * KP * 2;
constexpr int LDS_SCO = 36864;
constexpr int LDS_WU = LDS_SCO + 8 * 2048;

struct Stage { u32x4 k0, k1, v0, v1; };
__device__ __forceinline__ void stage_load(Stage& st, const bf16_t* kb, const bf16_t* vb, long pitch, int tid) {
    const int p0 = tid, p1 = tid + 512;
    st.k0 = *(const u32x4*)(kb + (long)(p0 >> 4) * pitch + (p0 & 15) * 8);
    st.k1 = *(const u32x4*)(kb + (long)(p1 >> 4) * pitch + (p1 & 15) * 8);
    st.v0 = *(const u32x4*)(vb + (long)(p0 >> 4) * pitch + (p0 & 15) * 8);
    st.v1 = *(const u32x4*)(vb + (long)(p1 >> 4) * pitch + (p1 & 15) * 8);
}
__device__ __forceinline__ void stage_load_k(Stage& st, const bf16_t* kb, long pitch, int tid) {
    const int p0 = tid, p1 = tid + 512;
    st.k0 = *(const u32x4*)(kb + (long)(p0 >> 4) * pitch + (p0 & 15) * 8);
    st.k1 = *(const u32x4*)(kb + (long)(p1 >> 4) * pitch + (p1 & 15) * 8);
}
__device__ __forceinline__ void stage_store_k(const Stage& st, LAS unsigned char* lds, int tid) {
    const int p0 = tid, p1 = tid + 512;
    *(LAS u32x4*)(lds + LDS_K + (p0 >> 4) * (KP * 2) + (p0 & 15) * 16) = st.k0;
    *(LAS u32x4*)(lds + LDS_K + (p1 >> 4) * (KP * 2) + (p1 & 15) * 16) = st.k1;
}
__device__ __forceinline__ void stage_store(const Stage& st, LAS unsigned char* lds, int tid) {
    const int p0 = tid, p1 = tid + 512;
    *(LAS u32x4*)(lds + LDS_K + (p0 >> 4) * (KP * 2) + (p0 & 15) * 16) = st.k0;
    *(LAS u32x4*)(lds + LDS_K + (p1 >> 4) * (KP * 2) + (p1 & 15) * 16) = st.k1;
    *(LAS u32x4*)(lds + LDS_V + (p0 >> 4) * (VPN * 2) + (p0 & 15) * 16) = st.v0;
    *(LAS u32x4*)(lds + LDS_V + (p1 >> 4) * (VPN * 2) + (p1 & 15) * 16) = st.v1;
}
template <int NRG>
__device__ __forceinline__ void qk_tile(LAS unsigned char* lds, const bf16x8 (&qf)[NRG][4], f32x4 (&sc)[NRG][4], int fr, int fq) {
#pragma unroll
    for (int s = 0; s < 4; ++s) {
#pragma unroll
        for (int rg = 0; rg < NRG; ++rg) sc[rg][s] = (f32x4){0.f, 0.f, 0.f, 0.f};
#pragma unroll
        for (int kk = 0; kk < 4; ++kk) {
            const bf16x8 kf = *(const LAS bf16x8*)(lds + LDS_K + (s * 16 + fr) * (KP * 2) + kk * 64 + fq * 16);
#pragma unroll
            for (int rg = 0; rg < NRG; ++rg) sc[rg][s] = __builtin_amdgcn_mfma_f32_16x16x32_bf16(kf, qf[rg][kk], sc[rg][s], 0, 0, 0);
        }
    }
}
typedef short s16x4 __attribute__((ext_vector_type(4)));
template <int NRG>
__device__ __forceinline__ void pv_tile(LAS unsigned char* lds, const bf16x8 (&pb)[NRG][2], f32x4 (&o)[NRG][8], int fr, int fq) {
    LAS unsigned char* vbase = lds + LDS_V + (4 * fq + (fr >> 2)) * (VPN * 2) + (fr & 3) * 8;
#pragma unroll
    for (int c = 0; c < 8; ++c)
#pragma unroll
        for (int u = 0; u < 2; ++u) {
            const s16x4 lo = __builtin_amdgcn_ds_read_tr16_b64_v4i16((LAS s16x4*)(vbase + (32 * u) * (VPN * 2) + c * 32));
            const s16x4 hi = __builtin_amdgcn_ds_read_tr16_b64_v4i16((LAS s16x4*)(vbase + (32 * u + 16) * (VPN * 2) + c * 32));
            const bf16x8 vf = {lo[0], lo[1], lo[2], lo[3], hi[0], hi[1], hi[2], hi[3]};
#pragma unroll
            for (int rg = 0; rg < NRG; ++rg) o[rg][c] = __builtin_amdgcn_mfma_f32_16x16x32_bf16(vf, pb[rg][u], o[rg][c], 0, 0, 0);
        }
}
__device__ __forceinline__ bf16x8 pack8(const f32x4 a, const f32x4 b) {
    u32x4 w = {cvt_pk_bf16(a[0], a[1]), cvt_pk_bf16(a[2], a[3]), cvt_pk_bf16(b[0], b[1]), cvt_pk_bf16(b[2], b[3])};
    return *reinterpret_cast<bf16x8*>(&w);
}
__device__ __forceinline__ void softmax_update(f32x4 (&x)[4], float& m, float& l, f32x4 (&o)[8], bf16x8 (&pb)[2]) {
    float mx = x[0][0];
#pragma unroll
    for (int s = 0; s < 4; ++s)
#pragma unroll
        for (int r = 0; r < 4; ++r) mx = fmaxf(mx, x[s][r]);
    mx = fmaxf(mx, __shfl_xor(mx, 16)); mx = fmaxf(mx, __shfl_xor(mx, 32));
    const float mn = fmaxf(m, mx);
    const float alpha = __builtin_amdgcn_exp2f(m - mn);
    m = mn;
    float ls = 0.f;
#pragma unroll
    for (int s = 0; s < 4; ++s)
#pragma unroll
        for (int r = 0; r < 4; ++r) { x[s][r] = __builtin_amdgcn_exp2f(x[s][r] - mn); ls += x[s][r]; }
    l = l * alpha + ls;
#pragma unroll
    for (int c = 0; c < 8; ++c) o[c] *= alpha;
    pb[0] = pack8(x[0], x[1]); pb[1] = pack8(x[2], x[3]);
}
template <bool MASK>
__device__ __forceinline__ void softmax_tile(f32x4 (&x)[4], float slope2, float base, int relb, unsigned W, float& m, float& l, f32x4 (&o)[8], bf16x8 (&pb)[2]) {
    float mx = -__builtin_inff();
#pragma unroll
    for (int s = 0; s < 4; ++s)
#pragma unroll
        for (int r = 0; r < 4; ++r) {
            const int k = 16 * s + r;
            float y = fmaf(x[s][r], C2, fmaf(slope2, (float)k, base));
            if (MASK) y = ((unsigned)(relb - k) <= W) ? y : -__builtin_inff();
            x[s][r] = y; mx = fmaxf(mx, y);
        }
    mx = fmaxf(mx, __shfl_xor(mx, 16)); mx = fmaxf(mx, __shfl_xor(mx, 32));
    float mn = m;
    if (!__all(mx - m <= 8.f)) {
        mn = fmaxf(m, mx);
        const float alpha = __builtin_amdgcn_exp2f(m - mn);
        m = mn; l *= alpha;
#pragma unroll
        for (int c = 0; c < 8; ++c) o[c] *= alpha;
    }
    float ls = 0.f;
#pragma unroll
    for (int s = 0; s < 4; ++s)
#pragma unroll
        for (int r = 0; r < 4; ++r) { x[s][r] = __builtin_amdgcn_exp2f(x[s][r] - mn); ls += x[s][r]; }
    l += ls;
    pb[0] = pack8(x[0], x[1]); pb[1] = pack8(x[2], x[3]);
}
__device__ __forceinline__ void store_o_row(bf16_t* dst, const f32x4 (&o)[8], float inv, int fq) {
#pragma unroll
    for (int c = 0; c < 8; ++c) {
        u32x2 w; w.x = cvt_pk_bf16(o[c][0] * inv, o[c][1] * inv); w.y = cvt_pk_bf16(o[c][2] * inv, o[c][3] * inv);
        *(u32x2*)(dst + c * 16 + fq * 4) = w;
    }
}

__device__ __forceinline__ void band_job(LAS unsigned char* lds, const bf16_t* qb, long qpitch, const bf16_t* kb, const bf16_t* vb, long kvpitch,
                                         int q0, int W, float slope2, bf16_t* ob, long opitch, float* lseb, long lsepitch) {
    int tid_ = threadIdx.x; asm volatile("" : "+v"(tid_));
    const int tid = tid_, wid = __builtin_amdgcn_readfirstlane(tid >> 6), lane = tid & 63, fr = lane & 15, fq = lane >> 4;
    bf16x8 qf[2][4]; f32x4 o[2][8]; float m[2], l[2]; int qi[2];
#pragma unroll
    for (int rg = 0; rg < 2; ++rg) {
        qi[rg] = q0 + wid * 32 + rg * 16 + fr;
#pragma unroll
        for (int kk = 0; kk < 4; ++kk) qf[rg][kk] = *(const bf16x8*)(qb + (long)qi[rg] * qpitch + kk * 32 + fq * 8);
#pragma unroll
        for (int c = 0; c < 8; ++c) o[rg][c] = (f32x4){0.f, 0.f, 0.f, 0.f};
        m[rg] = -1e30f; l[rg] = 0.f;
    }
    const int qa = q0 + wid * 32;
    const int kt_lo = (q0 - W > 0 ? q0 - W : 0) >> 6, kt_hi = (q0 + 255) >> 6;
    Stage st; stage_load(st, kb + (long)(kt_lo * 64) * kvpitch, vb + (long)(kt_lo * 64) * kvpitch, kvpitch, tid);
    for (int kt = kt_lo; kt <= kt_hi; ++kt) {
        __syncthreads();
        stage_store(st, lds, tid);
        __syncthreads();
        if (kt < kt_hi) stage_load(st, kb + (long)((kt + 1) * 64) * kvpitch, vb + (long)((kt + 1) * 64) * kvpitch, kvpitch, tid);
        const bool need = (kt * 64 <= qa + 31) && (kt * 64 + 63 >= qa - W);
        if (need) {
            bf16x8 pb[2][2]; f32x4 sc[2][4];
            qk_tile<2>(lds, qf, sc, fr, fq);
#pragma unroll
            for (int rg = 0; rg < 2; ++rg) {
                const int relb = qi[rg] - kt * 64 - fq * 4;
                const float base = -slope2 * (float)relb;
                softmax_tile<true>(sc[rg], slope2, base, relb, (unsigned)W, m[rg], l[rg], o[rg], pb[rg]);
            }
            pv_tile<2>(lds, pb, o, fr, fq);
        }
    }
#pragma unroll
    for (int rg = 0; rg < 2; ++rg) {
        float lt = l[rg]; lt += __shfl_xor(lt, 16); lt += __shfl_xor(lt, 32);
        const float inv = lt > 0.f ? 1.f / lt : 0.f;
        store_o_row(ob + (long)qi[rg] * opitch, o[rg], inv, fq);
        if (lseb && fq == 0) lseb[(long)qi[rg] * lsepitch] = (m[rg] + __log2f(lt)) * LN2;
    }
}

__device__ __forceinline__ void nsa_job(LAS unsigned char* lds, const bf16_t* proj, const bf16_t* ksv, const bf16_t* kc, const bf16_t* vc, bf16_t* ocmp, bf16_t* osel, int b, int g, int chunk, int half, bool dry = false) {
    int tid_ = threadIdx.x; asm volatile("" : "+v"(tid_));
    const int tid = tid_, wid = __builtin_amdgcn_readfirstlane(tid >> 6), lane = tid & 63, fr = lane & 15, fq = lane >> 4;
    const int t0 = chunk * 64, tq = t0 + half * 32 + wid * 4 + (fr & 3);
    const int head = fr >> 2, hq = g * 4 + head;
    const size_t rowbase = (size_t)(b * S_ + tq);
    const float slope2 = __builtin_amdgcn_exp2f(-(float)(hq + 1)) * LOG2E;
    bf16x8 qf[1][4]; f32x4 o[1][8]; float m = -1e30f, l = 0.f;
#pragma unroll
    for (int kk = 0; kk < 4; ++kk) qf[0][kk] = *(const bf16x8*)(proj + rowbase * NQ + 1024 + hq * 128 + kk * 32 + fq * 8);
    const bf16_t* kcb = kc + (size_t)(b * 2 + g) * 256 * 128; const bf16_t* vcb = vc + (size_t)(b * 2 + g) * 256 * 128;
    const int cmax = (t0 + 32) >> 4;
    const int ktc = (cmax >> 6) > 3 ? 3 : (cmax >> 6);
    Stage stA, stB;
    float imp[16];
#pragma unroll
    for (int i = 0; i < 16; ++i) imp[i] = 0.f;
#pragma unroll
    for (int c = 0; c < 8; ++c) o[0][c] = (f32x4){0.f, 0.f, 0.f, 0.f};
    {
        stage_load(stA, kcb, vcb, 128, tid);
        if (ktc >= 1) stage_load(stB, kcb + (size_t)64 * 128, vcb + (size_t)64 * 128, 128, tid);
#pragma unroll
        for (int kt = 0; kt < 4; ++kt) {
            if (kt <= ktc) {
                __syncthreads(); stage_store((kt & 1) ? stB : stA, lds, tid); __syncthreads();
                if (kt + 2 <= ktc) stage_load((kt & 1) ? stB : stA, kcb + (size_t)(kt + 2) * 64 * 128, vcb + (size_t)(kt + 2) * 64 * 128, 128, tid);
                f32x4 sc[1][4]; bf16x8 pb[1][2];
                qk_tile<1>(lds, qf, sc, fr, fq);
                const int relb = tq - 31 - 16 * (kt * 64 + fq * 4);
                float mx = -__builtin_inff();
#pragma unroll
                for (int s = 0; s < 4; ++s)
#pragma unroll
                    for (int r = 0; r < 4; ++r) {
                        const int rel = relb - 256 * s - 16 * r;
                        const float v = sc[0][s][r] * C2 - slope2 * (float)rel;
                        sc[0][s][r] = (rel >= 0) ? v : -__builtin_inff();
                        mx = fmaxf(mx, sc[0][s][r]);
                    }
                mx = fmaxf(mx, __shfl_xor(mx, 16)); mx = fmaxf(mx, __shfl_xor(mx, 32));
                const float mn = fmaxf(m, mx);
                const float alpha = __builtin_amdgcn_exp2f(m - mn);
                m = mn; l *= alpha;
#pragma unroll
                for (int c = 0; c < 8; ++c) o[0][c] *= alpha;
#pragma unroll
                for (int i = 0; i < 16; ++i) imp[i] *= alpha;
                float ls = 0.f;
#pragma unroll
                for (int s = 0; s < 4; ++s) {
#pragma unroll
                    for (int r = 0; r < 4; ++r) { sc[0][s][r] = __builtin_amdgcn_exp2f(sc[0][s][r] - mn); ls += sc[0][s][r]; }
                    const float own = (sc[0][s][0] + sc[0][s][1]) + (sc[0][s][2] + sc[0][s][3]);
                    const float recv = __shfl(sc[0][s][3], (lane - 16) & 63);
                    imp[kt * 4 + s] += own + (fq != 0 ? recv : 0.f);
                    if (kt * 4 + s + 1 < 16) imp[kt * 4 + s + 1] += (fq != 0 ? 0.f : recv);
                }
                l += ls;
                pb[0][0] = pack8(sc[0][0], sc[0][1]); pb[0][1] = pack8(sc[0][2], sc[0][3]);
                pv_tile<1>(lds, pb, o, fr, fq);
            }
        }
    }
    {
        float lt = l; lt += __shfl_xor(lt, 16); lt += __shfl_xor(lt, 32);
        const float inv = lt > 0.f ? 1.f / lt : 0.f;
#pragma unroll
        for (int i = 0; i < 16; ++i) imp[i] *= inv;
        if (!dry) store_o_row(ocmp + rowbase * 1024 + hq * 128, o[0], inv, fq);
    }
    float sco[16];
    LAS float* scw = (LAS float*)(lds + LDS_SCO + wid * 1024) + (fr & 3) * 64;
#pragma unroll
    for (int i = 0; i < 16; ++i) {
        float tot = imp[i] + __shfl_xor(imp[i], 4);
        tot = tot + __shfl_xor(tot, 8);
        const int n = 4 * i + fq;
        const bool valid = n <= chunk;
        const bool forced = (n == 0) || (valid && n > chunk - 2);
        sco[i] = valid ? tot + (forced ? 1000.f : 0.f) : -1.f;
        scw[n] = sco[i];
    }
    asm volatile("s_waitcnt lgkmcnt(0)" ::: "memory");
    int rank[16];
#pragma unroll
    for (int i = 0; i < 16; ++i) rank[i] = 0;
    for (int j = 0; j < 16; ++j) {
        const int n2 = head * 16 + j;
        const float v2 = scw[n2];
#pragma unroll
        for (int i = 0; i < 16; ++i) {
            const int n = 4 * i + fq;
            rank[i] += ((v2 > sco[i]) || (v2 == sco[i] && n2 < n)) ? 1 : 0;
        }
    }
    unsigned mlo = 0u, mhi = 0u;
#pragma unroll
    for (int i = 0; i < 16; ++i) {
        int rk = rank[i] + __shfl_xor(rank[i], 4);
        rk = rk + __shfl_xor(rk, 8);
        const int n = 4 * i + fq;
        const bool sel = (n <= chunk) && rk < 16;
        if (i < 8) mlo |= sel ? (1u << (n & 31)) : 0u; else mhi |= sel ? (1u << (n & 31)) : 0u;
    }
    mlo |= __shfl_xor(mlo, 16); mlo |= __shfl_xor(mlo, 32); mhi |= __shfl_xor(mhi, 16); mhi |= __shfl_xor(mhi, 32);
    unsigned wlo = mlo, whi = mhi;
#pragma unroll
    for (int x = 1; x < 4; x <<= 1) { wlo |= __shfl_xor(wlo, x); whi |= __shfl_xor(whi, x); }
    wlo = __builtin_amdgcn_readfirstlane(wlo); whi = __builtin_amdgcn_readfirstlane(whi);
    LAS unsigned* wu = (LAS unsigned*)(lds + LDS_WU);
    if (lane == 0) { wu[wid * 2] = wlo; wu[wid * 2 + 1] = whi; }
    __syncthreads();
    unsigned ulo = 0u, uhi = 0u;
#pragma unroll
    for (int w = 0; w < 8; ++w) { ulo |= wu[w * 2]; uhi |= wu[w * 2 + 1]; }
    ulo = __builtin_amdgcn_readfirstlane(ulo); uhi = __builtin_amdgcn_readfirstlane(uhi);
    const unsigned long long mymask = ((unsigned long long)mhi << 32) | mlo;
    const unsigned long long wmask = ((unsigned long long)whi << 32) | wlo;
    unsigned long long rem = ((unsigned long long)uhi << 32) | ulo;
    m = -1e30f; l = 0.f;
#pragma unroll
    for (int c = 0; c < 8; ++c) o[0][c] = (f32x4){0.f, 0.f, 0.f, 0.f};
    const bf16_t* ksb = ksv + (size_t)(b * 2 + g) * 4096 * 128; const bf16_t* vsb = ksv + (size_t)4 * 2 * 4096 * 128 + (size_t)(b * 2 + g) * 4096 * 128;
#define NSA_POP(var) do { if (rem != 0ull) { var = __builtin_ctzll(rem); rem &= rem - 1; } else var = -1; } while (0)
#define NSA_SEL_COMPUTE(n) do { if (!dry && ((wmask >> (n)) & 1ull)) { \
        f32x4 sc[1][4]; bf16x8 pb[1][2]; \
        qk_tile<1>(lds, qf, sc, fr, fq); \
        const bool mysel = (mymask >> (n)) & 1ull; \
        const int relb = tq - (n) * 64 - fq * 4; \
        const float base = mysel ? -slope2 * (float)relb : -__builtin_inff(); \
        if ((n) < chunk) softmax_tile<false>(sc[0], slope2, base, relb, 0x7fffffffu, m, l, o[0], pb[0]); \
        else softmax_tile<true>(sc[0], slope2, base, relb, 0x7fffffffu, m, l, o[0], pb[0]); \
        pv_tile<1>(lds, pb, o, fr, fq); } } while (0)
    {
        int na, nb, nc, nd;
        NSA_POP(na); NSA_POP(nb);
        stage_load(stA, ksb + (size_t)(na * 64) * 128, vsb + (size_t)(na * 64) * 128, 128, tid);
        if (nb >= 0) stage_load(stB, ksb + (size_t)(nb * 64) * 128, vsb + (size_t)(nb * 64) * 128, 128, tid);
        for (;;) {
            __syncthreads(); stage_store(stA, lds, tid); __syncthreads();
            NSA_POP(nc);
            if (nc >= 0) stage_load(stA, ksb + (size_t)(nc * 64) * 128, vsb + (size_t)(nc * 64) * 128, 128, tid);
            NSA_SEL_COMPUTE(na);
            if (nb < 0) break;
            __syncthreads(); stage_store(stB, lds, tid); __syncthreads();
            NSA_POP(nd);
            if (nd >= 0) stage_load(stB, ksb + (size_t)(nd * 64) * 128, vsb + (size_t)(nd * 64) * 128, 128, tid);
            NSA_SEL_COMPUTE(nb);
            if (nc < 0) break;
            na = nc; nb = nd;
        }
    }
#undef NSA_POP
#undef NSA_SEL_COMPUTE
    {
        float lt = l; lt += __shfl_xor(lt, 16); lt += __shfl_xor(lt, 32);
        const float iv = lt > 0.f ? 1.f / lt : 0.f;
        if (!dry) store_o_row(osel + rowbase * 1024 + hq * 128, o[0], iv, fq);
    }
}

__device__ __forceinline__ void transpose_item(const float* W, int K, int N, bf16_t* WT, int item, int nblk, LAS float* scr, int lane, const float* gk, int mode, int off) {
    const int kb = item / nblk, nb = item % nblk, k0 = 64 * kb, n0 = 32 * nb;
    const int nn = n0 + (lane & 31);
    const bool nok = nn < N;
    float v[32];
#pragma unroll
    for (int i = 0; i < 32; ++i) v[i] = nok ? __builtin_nontemporal_load(W + (size_t)(k0 + 2 * i + (lane >> 5)) * N + nn) : 0.f;
    if (gk) {
#pragma unroll
        for (int i = 0; i < 32; ++i) v[i] *= gk[k0 + 2 * i + (lane >> 5)];
    }
#pragma unroll
    for (int i = 0; i < 32; ++i) scr[(2 * i + (lane >> 5)) * 33 + (lane & 31)] = v[i];
    asm volatile("s_waitcnt lgkmcnt(0)" ::: "memory");
    const int c = lane & 7;
#pragma unroll
    for (int j = 0; j < 4; ++j) {
        const int n = (lane >> 3) + 8 * j; const LAS float* s = scr + (8 * c) * 33 + n;
        u32x4 ov; ov.x = cvt_pk_bf16(s[0 * 33], s[1 * 33]); ov.y = cvt_pk_bf16(s[2 * 33], s[3 * 33]); ov.z = cvt_pk_bf16(s[4 * 33], s[5 * 33]); ov.w = cvt_pk_bf16(s[6 * 33], s[7 * 33]);
        const int ng = n0 + n;
        const int row = mode ? ((ng >> 7) * 256 + (ng & 127) + off) : ng;
        *(u32x4*)(WT + (size_t)row * K + k0 + 8 * c) = ov;
    }
    asm volatile("s_waitcnt lgkmcnt(0)" ::: "memory");
}

__device__ __forceinline__ void grid_barrier(unsigned* bar, unsigned target) {
    asm volatile("s_waitcnt vmcnt(0) lgkmcnt(0)" ::: "memory");
    __syncthreads();
    if (threadIdx.x == 0) {
        __builtin_amdgcn_fence(__ATOMIC_RELEASE, "agent");
        asm volatile("s_waitcnt vmcnt(0)" ::: "memory");
        __hip_atomic_fetch_add(bar, 1u, __ATOMIC_RELAXED, __HIP_MEMORY_SCOPE_AGENT);
        while (__hip_atomic_load(bar, __ATOMIC_RELAXED, __HIP_MEMORY_SCOPE_AGENT) < target) __builtin_amdgcn_s_sleep(1);
        __builtin_amdgcn_fence(__ATOMIC_ACQUIRE, "agent");
        asm volatile("s_waitcnt vmcnt(0)" ::: "memory");
    }
    __syncthreads();
}
#define GRID_SYNC() do { ++nbar; grid_barrier((unsigned*)(p.ws + WS_BAR), nbar * (unsigned)G); } while (0)
struct Params {
    const float* x; const float* norm1_g; const float* w_in;
    const float* pe_k; const float* w1_k; const float* w2_k; const float* pe_v; const float* w1_v; const float* w2_v;
    const float* gn_a; const float* gn_b; const float* w_out; const float* norm2_g; const float* w_gate; const float* w_up; const float* w_down; const float* final_g;
    float* out; unsigned char* ws;
};

__global__ void __launch_bounds__(512, 2) fwd_mega(Params p) {
    extern __shared__ __attribute__((aligned(16))) unsigned char lds_raw[];
    LAS unsigned char* lds = (LAS unsigned char*)lds_raw;
    cg::grid_group grid = cg::this_grid();
    const int tid = threadIdx.x, lane = tid & 63, wid = __builtin_amdgcn_readfirstlane(tid >> 6);
    const int G = gridDim.x, bx = blockIdx.x;
    unsigned nbar = 0;
#define ctl ((unsigned*)(p.ws + WS_CTL))
#define rsq2 ((float*)(p.ws + WS_RSQ2))
#define rsq3 ((float*)(p.ws + WS_RSQ3))
#define biasc ((float*)(p.ws + WS_BIASC))
#define biasp ((float*)(p.ws + WS_BIASP))
#define Wt_in ((bf16_t*)(p.ws + WS_WIN))
#define Wt_out ((bf16_t*)(p.ws + WS_WOUT))
#define Wt_gu ((bf16_t*)(p.ws + WS_WGU))
#define Wt_dn ((bf16_t*)(p.ws + WS_WDN))
#define Wt_c1 ((bf16_t*)(p.ws + WS_WC1))
#define W2t ((bf16_t*)(p.ws + WS_W2T))
#define craw ((bf16_t*)(p.ws + WS_CRAW))
#define hid ((bf16_t*)(p.ws + WS_HID))
#define kvc ((bf16_t*)(p.ws + WS_KVC))
#define lse ((float*)(p.ws + WS_LSE))
#define hn ((bf16_t*)(p.ws + WS_R1))
#define mixed ((bf16_t*)(p.ws + WS_R1))
#define proj ((bf16_t*)(p.ws + WS_PROJ))
#define act ((bf16_t*)(p.ws + WS_PROJ))
#define kva ((bf16_t*)(p.ws + WS_KVA))
#define kvs ((bf16_t*)(p.ws + WS_KVS))
#define ob ((bf16_t*)(p.ws + WS_OB))
#define hb ((bf16_t*)(p.ws + WS_OB))
#define oA ((bf16_t*)p.out)
    LAS int* slot = (LAS int*)(lds + LDS_SLOT);

    {
        const int gt = bx * 512 + tid;
        if (gt < T_) { rsq2[gt] = 0.f; rsq3[gt] = 0.f; }
        if (bx == 0 && tid < 16) ctl[tid] = 0u;
        for (int job = bx; job < 64; job += G) {
            const int which = job >> 5, ks = job & 31;
            const float* pe = which ? p.pe_v : p.pe_k; const float* w1 = which ? p.w1_v : p.w1_k;
            const int n = tid & 255, kh = tid >> 8, kbeg = ks * 128 + kh * 64;
            float a = 0.f;
#pragma unroll 16
            for (int k = 0; k < 64; ++k) a += pe[kbeg + k] * w1[(size_t)(kbeg + k) * 256 + n];
            biasp[(size_t)(which * 64 + ks * 2 + kh) * 256 + n] = a;
        }
        LAS float* scr = (LAS float*)(lds + wid * 8704);
        const int gw = bx * 8 + wid, NGW = G * 8;
        constexpr int I_IN = 32 * 184, I_OUT = 32 * 64, I_G = 32 * 176, I_DN = 88 * 64, I_C1 = 64 * 8, I_W2 = 4 * 4;
        constexpr int NITEMS = I_IN + I_OUT + 2 * I_G + 2 * I_C1 + 2 * I_W2;
        for (int it = gw; it < NITEMS; it += NGW) {
            int r = it;
            if (r < I_IN) { transpose_item(p.w_in, DM, PIN, Wt_in, r, 184, scr, lane, nullptr, 0, 0); continue; } r -= I_IN;
            if (r < I_OUT) { transpose_item(p.w_out, DM, DM, Wt_out, r, 64, scr, lane, nullptr, 0, 0); continue; } r -= I_OUT;
            if (r < I_G) { transpose_item(p.w_gate, DM, FF, Wt_gu, r, 176, scr, lane, p.norm2_g, 1, 0); continue; } r -= I_G;
            if (r < I_G) { transpose_item(p.w_up, DM, FF, Wt_gu, r, 176, scr, lane, p.norm2_g, 1, 128); continue; } r -= I_G;
            if (r < I_C1) { transpose_item(p.w1_k, 4096, 256, Wt_c1, r, 8, scr, lane, nullptr, 0, 0); continue; } r -= I_C1;
            if (r < I_C1) { transpose_item(p.w1_v, 4096, 256, Wt_c1 + 256 * 4096, r, 8, scr, lane, nullptr, 0, 0); continue; } r -= I_C1;
            if (r < I_W2) { transpose_item(p.w2_k, 256, 128, W2t, r, 4, scr, lane, nullptr, 0, 0); continue; } r -= I_W2;
            transpose_item(p.w2_v, 256, 128, W2t + 128 * 256, r, 4, scr, lane, nullptr, 0, 0);
        }
        for (int row = gw; row < T_; row += NGW) {
            const f32x4* xr = (const f32x4*)(p.x + (size_t)row * DM) + lane;
            f32x4 v[8]; float ss = 0.f;
#pragma unroll
            for (int j = 0; j < 8; ++j) { v[j] = __builtin_nontemporal_load(xr + 64 * j); ss += (v[j][0] * v[j][0] + v[j][1] * v[j][1]) + (v[j][2] * v[j][2] + v[j][3] * v[j][3]); }
            const float r = rsqrtf(wave_sum(ss) * (1.f / DM) + EPS);
            u32x2* o8 = (u32x2*)(hn + (size_t)row * DM) + lane;
#pragma unroll
            for (int j = 0; j < 8; ++j) {
                const f32x4 gg = *((const f32x4*)p.norm1_g + lane + 64 * j);
                u32x2 w; w.x = cvt_pk_bf16(v[j][0] * r * gg[0], v[j][1] * r * gg[1]); w.y = cvt_pk_bf16(v[j][2] * r * gg[2], v[j][3] * r * gg[3]);
                o8[64 * j] = w;
            }
        }
    }
    asm volatile("s_waitcnt vmcnt(0) lgkmcnt(0)" ::: "memory");
    grid.sync();
    asm volatile("s_waitcnt vmcnt(0)" ::: "memory");

    if (bx < 2 && tid < 256) {
        float sacc = 0.f;
#pragma unroll 16
        for (int j = 0; j < 64; ++j) sacc += biasp[(size_t)(bx * 64 + j) * 256 + tid];
        biasc[bx * 256 + tid] = sacc;
    }
    {
        pg8::Gemm g{hn, Wt_in, T_, NP, DM, DM, DM}; pg8::StaticOrder S; S.init(T_, NP, G, bx);
        EpiProj E{proj, kva, kvs, craw};
        pg8::gemm_phase<EpiProj, pg8::StaticOrder>(lds, g, S, E);
        const int nunits = (T_ / 256) * (NP / 256), full = nunits / G, rem = nunits - full * G;
        if (rem > 0 && bx >= rem) {
            LAS float* scr = (LAS float*)(lds + wid * 8704);
            const int nidle = G - rem;
            for (int it = (bx - rem) * 8 + wid; it < 88 * 64; it += nidle * 8) transpose_item(p.w_down, FF, DM, Wt_dn, it, 64, scr, lane, nullptr, 0, 0);
        } else if (rem == 0) {
            LAS float* scr = (LAS float*)(lds + wid * 8704);
            for (int it = bx * 8 + wid; it < 88 * 64; it += G * 8) transpose_item(p.w_down, FF, DM, Wt_dn, it, 64, scr, lane, nullptr, 0, 0);
        }
    }
    GRID_SYNC();

    for (int job = bx; job < 16; job += G) {
        {
            const int which = job >> 3, bg = job & 7;
            bf16_t* hd = hid + (size_t)(which * 8 + bg) * 256 * 256;
            pg8::Gemm g{craw + (size_t)which * (8 * 4096 * 128), Wt_c1 + (size_t)which * 256 * 4096, 2048, 256, 4096, 2048, 4096};
            pg8::SingleOrder S{bg};
            EpiHid E{hd, biasc + which * 256};
            pg8::gemm_phase<EpiHid, pg8::SingleOrder>(lds, g, S, E);
        }
        __syncthreads();
    }
    for (;;) {
        __syncthreads();
        if (tid == 0) *slot = (int)atomicAdd(ctl + 0, 1u);
        __syncthreads();
        const int job = *slot;
        if (job >= 512 + 1536) break;
        if (job < 512) {
            const int j = job, qt = j & 15, hh = (j >> 4) & 7, b = j >> 7;
            const float slope2 = __builtin_amdgcn_exp2f(-(float)(hh + 1)) * LOG2E;
            const bf16_t* kwb = kvs + (size_t)2 * 4 * 2 * 4096 * 128 + (size_t)(b * 2 + (hh >> 2)) * 4096 * 128;
            band_job(lds, proj + (size_t)b * S_ * NQ + 1024 + hh * 128, NQ, kwb, kwb + (size_t)4 * 2 * 4096 * 128, 128,
                     qt * 256, 511, slope2, ob + (size_t)2 * T_ * 1024 + (size_t)b * S_ * 1024 + hh * 128, 1024, nullptr, 0);
        } else {
            const int j = job - 512, sub = j & 15, hh = (j >> 4) & 7, b = (j >> 7) & 3, cfg = j >> 9;
            const int dil = cfg == 0 ? 1 : (cfg == 1 ? 4 : 16);
            const int nqt = 16 / dil;
            const int r = sub / nqt, qt = sub % nqt;
            const float slope2 = __builtin_amdgcn_exp2f(-0.5f * (float)(2 * hh + 1)) * (float)dil * LOG2E;
            const bf16_t* kab = kva + ((size_t)(b * 8 + hh) * 4096 + r) * 128;
            band_job(lds, proj + (size_t)(b * S_ + r) * NQ + hh * 128, (long)dil * NQ, kab, kab + (size_t)4 * 8 * 4096 * 128, (long)dil * 128, qt * 256, 128, slope2,
                     oA + (size_t)cfg * T_ * 1024 + (size_t)(b * S_ + r) * 1024 + hh * 128, (long)dil * 1024,
                     lse + (size_t)cfg * T_ * 8 + (size_t)(b * S_ + r) * 8 + hh, (long)dil * 8);
        }
    }
    GRID_SYNC();

    for (int grp = bx; grp < 256; grp += G) {
        const int which = grp >> 7, bg = (grp >> 4) & 7, r0 = (grp & 15) * 16;
        const u32x4* wsrc = (const u32x4*)(W2t + (size_t)which * 128 * 256);
        const u32x4* hsrc = (const u32x4*)(hid + ((size_t)(which * 8 + bg) * 256 + r0) * 256);
        __syncthreads();
        for (int i = tid; i < 4096; i += 512) *(LAS u32x4*)(lds + i * 16) = wsrc[i];
        *(LAS u32x4*)(lds + 65536 + tid * 16) = hsrc[tid];
        __syncthreads();
        const int d = tid & 127, rq = tid >> 7;
        const LAS u32x4* wl = (const LAS u32x4*)(lds + d * 512);
        float acc2[4] = {0.f, 0.f, 0.f, 0.f};
        for (int jb = 0; jb < 32; ++jb) {
            const u32x4 wv = wl[(jb + d) & 31];
            const int jc = (jb + d) & 31;
#pragma unroll
            for (int r = 0; r < 4; ++r) {
                const u32x4 hv = *(const LAS u32x4*)(lds + 65536 + (rq * 4 + r) * 512 + jc * 16);
#pragma unroll
                for (int e = 0; e < 4; ++e) acc2[r] += bf_lo(wv[e]) * bf_lo(hv[e]) + bf_hi(wv[e]) * bf_hi(hv[e]);
            }
        }
        bf16_t* dstb = kvc + ((size_t)(which * 8 + bg) * 256 + r0) * 128;
#pragma unroll
        for (int r = 0; r < 4; ++r) {
            const int c = r0 + rq * 4 + r;
            const unsigned w16 = cvt_pk_bf16(c == 255 ? 0.f : acc2[r], 0.f);
            dstb[(size_t)(rq * 4 + r) * 128 + d] = (bf16_t)(w16 & 0xffffu);
        }
    }
    GRID_SYNC();

    for (;;) {
        __syncthreads();
        if (tid == 0) *slot = (int)atomicAdd(ctl + 1, 1u);
        __syncthreads();
        const int job = *slot;
        if (job >= 1024) break;
        const int chunk = 63 - (job >> 4), bg = job & 7, half = (job >> 3) & 1;
        nsa_job(lds, proj, kvs, kvc, kvc + (size_t)8 * 256 * 128, ob, ob + (size_t)T_ * 1024, bg >> 1, bg & 1, chunk, half);
    }
    GRID_SYNC();

    {
        const int gw = bx * 8 + wid, NGW = G * 8;
        for (int row = gw; row < T_; row += NGW) {
            u32x4 xa[3][2], xb[3][2];
#pragma unroll
            for (int i = 0; i < 3; ++i)
#pragma unroll
                for (int q = 0; q < 2; ++q) {
                    xa[i][q] = __builtin_nontemporal_load((const u32x4*)(oA + (size_t)(i * T_ + row) * 1024 + q * 512 + lane * 8));
                    xb[i][q] = __builtin_nontemporal_load((const u32x4*)(ob + (size_t)(i * T_ + row) * 1024 + q * 512 + lane * 8));
                }
            float o[16]; float ss = 0.f;
#pragma unroll
            for (int q = 0; q < 2; ++q) {
                const int h = q * 4 + (lane >> 4);
                const float l0 = lse[(size_t)row * 8 + h], l1 = lse[(size_t)(T_ + row) * 8 + h], l2 = lse[(size_t)(2 * T_ + row) * 8 + h];
                const float mx = fmaxf(l0, fmaxf(l1, l2));
                float w0 = __expf(l0 - mx), w1 = __expf(l1 - mx), w2 = __expf(l2 - mx);
                const float wi = 1.f / (w0 + w1 + w2); w0 *= wi; w1 *= wi; w2 *= wi;
#pragma unroll
                for (int e = 0; e < 4; ++e) {
                    o[q * 8 + 2 * e] = w0 * bf_lo(xa[0][q][e]) + w1 * bf_lo(xa[1][q][e]) + w2 * bf_lo(xa[2][q][e]);
                    o[q * 8 + 2 * e + 1] = w0 * bf_hi(xa[0][q][e]) + w1 * bf_hi(xa[1][q][e]) + w2 * bf_hi(xa[2][q][e]);
                }
            }
#pragma unroll
            for (int e = 0; e < 16; ++e) ss += o[e] * o[e];
            float r = rsqrtf(wave_sum(ss) * (1.f / 1024.f) + EPS);
#pragma unroll
            for (int q = 0; q < 2; ++q) {
                const f32x4 ga = *(const f32x4*)(p.gn_a + q * 512 + lane * 8), gb = *(const f32x4*)(p.gn_a + q * 512 + lane * 8 + 4);
                u32x4 w;
                w.x = cvt_pk_bf16(o[q * 8 + 0] * r * ga[0], o[q * 8 + 1] * r * ga[1]); w.y = cvt_pk_bf16(o[q * 8 + 2] * r * ga[2], o[q * 8 + 3] * r * ga[3]);
                w.z = cvt_pk_bf16(o[q * 8 + 4] * r * gb[0], o[q * 8 + 5] * r * gb[1]); w.w = cvt_pk_bf16(o[q * 8 + 6] * r * gb[2], o[q * 8 + 7] * r * gb[3]);
                *(u32x4*)(mixed + (size_t)row * DM + q * 512 + lane * 8) = w;
            }
            ss = 0.f;
#pragma unroll
            for (int q = 0; q < 2; ++q) {
                const int h = q * 4 + (lane >> 4);
                const bf16_t* gp = proj + (size_t)row * NQ + 2048 + h * 3;
                const float g0 = 1.f / (1.f + __expf(-bf1(gp[0]))), g1 = 1.f / (1.f + __expf(-bf1(gp[1]))), g2 = 1.f / (1.f + __expf(-bf1(gp[2])));
#pragma unroll
                for (int e = 0; e < 4; ++e) {
                    o[q * 8 + 2 * e] = g0 * bf_lo(xb[0][q][e]) + g1 * bf_lo(xb[1][q][e]) + g2 * bf_lo(xb[2][q][e]);
                    o[q * 8 + 2 * e + 1] = g0 * bf_hi(xb[0][q][e]) + g1 * bf_hi(xb[1][q][e]) + g2 * bf_hi(xb[2][q][e]);
                }
            }
#pragma unroll
            for (int e = 0; e < 16; ++e) ss += o[e] * o[e];
            r = rsqrtf(wave_sum(ss) * (1.f / 1024.f) + EPS);
#pragma unroll
            for (int q = 0; q < 2; ++q) {
                const f32x4 ga = *(const f32x4*)(p.gn_b + q * 512 + lane * 8), gb = *(const f32x4*)(p.gn_b + q * 512 + lane * 8 + 4);
                u32x4 w;
                w.x = cvt_pk_bf16(o[q * 8 + 0] * r * ga[0], o[q * 8 + 1] * r * ga[1]); w.y = cvt_pk_bf16(o[q * 8 + 2] * r * ga[2], o[q * 8 + 3] * r * ga[3]);
                w.z = cvt_pk_bf16(o[q * 8 + 4] * r * gb[0], o[q * 8 + 5] * r * gb[1]); w.w = cvt_pk_bf16(o[q * 8 + 6] * r * gb[2], o[q * 8 + 7] * r * gb[3]);
                *(u32x4*)(mixed + (size_t)row * DM + 1024 + q * 512 + lane * 8) = w;
            }
        }
    }
    GRID_SYNC();

    {
        pg8::Gemm g{mixed, Wt_out, T_, DM, DM, DM, DM}; pg8::StaticOrder S; S.init(T_, DM, G, bx);
        EpiWout E{p.x, hb, rsq2};
        pg8::gemm_phase<EpiWout, pg8::StaticOrder>(lds, g, S, E);
    }
    GRID_SYNC();

    {
        pg8::Gemm g{hb, Wt_gu, T_, 2 * FF, DM, DM, DM}; pg8::StaticOrder S; S.init(T_, 2 * FF, G, bx);
        EpiSwiglu E{act, rsq2};
        pg8::gemm_phase<EpiSwiglu, pg8::StaticOrder>(lds, g, S, E);
    }
    GRID_SYNC();

    {
        pg8::Gemm g{act, Wt_dn, T_, DM, FF, FF, FF}; pg8::StaticOrder S; S.init(T_, DM, G, bx);
        EpiDown E{hb, mixed, rsq3};
        pg8::gemm_phase<EpiDown, pg8::StaticOrder>(lds, g, S, E);
    }
    GRID_SYNC();

    {
        const int gw = bx * 8 + wid, NGW = G * 8;
        for (int row0 = gw; row0 < T_; row0 += 4 * NGW) {
            u32x4 yv[4][4];
#pragma unroll
            for (int i = 0; i < 4; ++i) {
                const int row = row0 + i * NGW;
                if (row < T_) {
#pragma unroll
                    for (int q = 0; q < 4; ++q) yv[i][q] = __builtin_nontemporal_load((const u32x4*)(mixed + (size_t)row * DM + q * 512 + lane * 8));
                }
            }
#pragma unroll
            for (int i = 0; i < 4; ++i) {
                const int row = row0 + i * NGW;
                if (row < T_) {
                    const float r = rsqrtf(rsq3[row] * (1.f / DM) + EPS);
#pragma unroll
                    for (int q = 0; q < 4; ++q) {
                        const f32x4 ga = *(const f32x4*)(p.final_g + q * 512 + lane * 8), gb = *(const f32x4*)(p.final_g + q * 512 + lane * 8 + 4);
                        const u32x4 w = yv[i][q];
                        f32x4 o0, o1;
                        o0[0] = bf_lo(w.x) * r * ga[0]; o0[1] = bf_hi(w.x) * r * ga[1]; o0[2] = bf_lo(w.y) * r * ga[2]; o0[3] = bf_hi(w.y) * r * ga[3];
                        o1[0] = bf_lo(w.z) * r * gb[0]; o1[1] = bf_hi(w.z) * r * gb[1]; o1[2] = bf_lo(w.w) * r * gb[2]; o1[3] = bf_hi(w.w) * r * gb[3];
                        float* dst = p.out + (size_t)row * DM + q * 512 + lane * 8;
                        __builtin_nontemporal_store(o0, (f32x4*)dst); __builtin_nontemporal_store(o1, (f32x4*)(dst + 4));
                    }
                }
            }
        }
    }
}

extern "C" void kernel_launch(void* const* d_in, const int* in_sizes, int n_in, void* d_out, int out_size, void* d_ws, size_t ws_size, hipStream_t stream) {
    static int grid_blocks = 0;
    if (grid_blocks == 0) {
        if (n_in != 17 || out_size != T_ * DM || ws_size < WS_END) { fprintf(stderr, "kernel_launch: unexpected shapes / workspace (n_in %d out %d ws %zu need %zu)\n", n_in, out_size, ws_size, (size_t)WS_END); grid_blocks = -1; return; }
        int dev = 0, cus = 0, per_cu = 0;
        hipGetDevice(&dev);
        hipDeviceGetAttribute(&cus, hipDeviceAttributeMultiprocessorCount, dev);
        if (hipFuncSetAttribute((const void*)fwd_mega, hipFuncAttributeMaxDynamicSharedMemorySize, LDS_BYTES) != hipSuccess) { fprintf(stderr, "kernel_launch: hipFuncSetAttribute failed\n"); grid_blocks = -1; return; }
        if (hipOccupancyMaxActiveBlocksPerMultiprocessor(&per_cu, (const void*)fwd_mega, 512, LDS_BYTES) != hipSuccess || per_cu < 1) { fprintf(stderr, "kernel_launch: occupancy query failed (%d)\n", per_cu); per_cu = 1; (void)hipGetLastError(); }
        if (per_cu > 1) per_cu = 1;
        grid_blocks = cus * per_cu;
    }
    if (grid_blocks < 0) return;
    Params p{};
    p.x = (const float*)d_in[0]; p.norm1_g = (const float*)d_in[1]; p.w_in = (const float*)d_in[2];
    p.pe_k = (const float*)d_in[3]; p.w1_k = (const float*)d_in[4]; p.w2_k = (const float*)d_in[5];
    p.pe_v = (const float*)d_in[6]; p.w1_v = (const float*)d_in[7]; p.w2_v = (const float*)d_in[8];
    p.gn_a = (const float*)d_in[9]; p.gn_b = (const float*)d_in[10]; p.w_out = (const float*)d_in[11]; p.norm2_g = (const float*)d_in[12];
    p.w_gate = (const float*)d_in[13]; p.w_up = (const float*)d_in[14]; p.w_down = (const float*)d_in[15]; p.final_g = (const float*)d_in[16];
    p.out = (float*)d_out; p.ws = (unsigned char*)d_ws;
    if (hipMemsetAsync((char*)d_ws + WS_BAR, 0, 256, stream) != hipSuccess) { fprintf(stderr, "kernel_launch: memset failed\n"); return; }
    void* args[] = {&p};
    hipError_t e = hipLaunchCooperativeKernel((const void*)fwd_mega, dim3(grid_blocks), dim3(512), args, LDS_BYTES, stream);
    if (e != hipSuccess) fprintf(stderr, "cooperative launch failed: %s (grid %d)\n", hipGetErrorString(e), grid_blocks);
}
```

```cpp
#include <hip/hip_runtime.h>
#include <hip/hip_cooperative_groups.h>
#include <cstdio>
#include <cstdint>
namespace cg = cooperative_groups;

#define LAS __attribute__((address_space(3)))
typedef unsigned short bf16_t;
typedef short bf16x8 __attribute__((ext_vector_type(8)));
typedef float f32x4 __attribute__((ext_vector_type(4)));
typedef unsigned u32x4 __attribute__((ext_vector_type(4)));
typedef unsigned u32x2 __attribute__((ext_vector_type(2)));

constexpr int T_ = 16384, S_ = 4096, DM = 2048, PIN = 5656, NP = 5888, FF = 5632;
constexpr float EPS = 1e-6f;
constexpr float LOG2E = 1.4426950408889634f, LN2 = 0.6931471805599453f;
constexpr float C2 = 0.08838834764831845f * 1.4426950408889634f;

constexpr size_t al256(size_t x) { return (x + 255) & ~(size_t)255; }
constexpr size_t WS_CTL = 0;
constexpr size_t WS_BAR = 2048;
constexpr size_t WS_RSQ2 = 4096;
constexpr size_t WS_RSQ3 = WS_RSQ2 + (size_t)T_ * 4;
constexpr size_t WS_BIASC = WS_RSQ3 + (size_t)T_ * 4;
constexpr size_t WS_BIASP = al256(WS_BIASC + 2048);
constexpr size_t WS_WIN = al256(WS_BIASP + 131072);
constexpr size_t WS_WOUT = WS_WIN + (size_t)NP * DM * 2;
constexpr size_t WS_WGU = WS_WOUT + (size_t)DM * DM * 2;
constexpr size_t WS_WDN = WS_WGU + (size_t)2 * FF * DM * 2;
constexpr size_t WS_WC1 = WS_WDN + (size_t)DM * FF * 2;
constexpr size_t WS_W2T = WS_WC1 + (size_t)2 * 256 * 4096 * 2;
constexpr size_t WS_HID = WS_W2T + (size_t)2 * 128 * 256 * 2;
constexpr size_t WS_KVC = WS_HID + (size_t)2 * 8 * 256 * 256 * 2;
constexpr size_t WS_LSE = WS_KVC + (size_t)2 * 8 * 256 * 128 * 2;
constexpr size_t WS_R1 = WS_LSE + (size_t)3 * T_ * 8 * 4;
constexpr int NQ = 2304;
constexpr size_t WS_PROJ = WS_R1 + (size_t)T_ * DM * 2;
constexpr size_t WS_KVA = WS_PROJ + (size_t)T_ * NQ * 2;
constexpr size_t WS_KVS = WS_KVA + (size_t)2 * 4 * 8 * 4096 * 128 * 2;
constexpr size_t WS_CRAW = WS_KVS + (size_t)4 * 4 * 2 * 4096 * 128 * 2;
constexpr size_t WS_OB = WS_CRAW + (size_t)2 * 8 * 4096 * 128 * 2 + 16384;
constexpr size_t WS_END = WS_OB + (size_t)3 * T_ * 1024 * 2;
static_assert(WS_OB - WS_PROJ >= (size_t)T_ * FF * 2, "act overlay");
static_assert(WS_END <= (size_t)536870912, "workspace");

constexpr int LDS_BYTES = 131072 + 1024;
constexpr int LDS_SLOT = 131072;

typedef __bf16 bf16v2 __attribute__((ext_vector_type(2)));
typedef float f32x2 __attribute__((ext_vector_type(2)));
__device__ __forceinline__ unsigned cvt_pk_bf16(float lo, float hi) { f32x2 v = {lo, hi}; bf16v2 b = __builtin_convertvector(v, bf16v2); return __builtin_bit_cast(unsigned, b); }
__device__ __forceinline__ float bf_lo(unsigned w) { return __uint_as_float(w << 16); }
__device__ __forceinline__ float bf_hi(unsigned w) { return __uint_as_float(w & 0xffff0000u); }
__device__ __forceinline__ float bf1(bf16_t b) { return __uint_as_float(((unsigned)b) << 16); }
__device__ __forceinline__ float wave_sum(float v) {
#pragma unroll
    for (int o = 1; o < 64; o <<= 1) v += __shfl_xor(v, o);
    return v;
}

namespace pg8 {
constexpr int BM = 256, BK = 64, HALF = 128, HTB = HALF * BK * 2, STAGE_BYTES = 8 * HTB, NXCD = 8, WGM = 4;
__host__ __device__ __forceinline__ int lds_byte(int r, int c) { const int st = (r >> 4) * 2 + (c >> 5), rr = r & 15, cc = c & 31, ob = rr * 64 + cc * 2; return st * 1024 + (ob ^ (((ob >> 9) & 1) << 5)); }
__host__ __device__ __forceinline__ void stage_rc(int b, int& R, int& C) { const int st = b / 1024, sb = b % 1024, swz = sb ^ (((sb >> 9) & 1) << 5); R = (st >> 1) * 16 + swz / 64; C = (st & 1) * 32 + (swz % 64) / 2; }
__host__ __device__ __forceinline__ int perm32(int rho) { const int n = rho >> 4, i = rho & 15; return 8 * (i >> 2) + 4 * n + (i & 3); }
struct Unit { int pm, pn; };
struct Gemm { const bf16_t* A; const bf16_t* Bt; int M, N, K, lda, ldb; };
struct StaticOrder {
    int nM, nN, nwg, G, c;
    __device__ void init(int M, int N, int G_, int c_) { nM = M / BM; nN = N / BM; nwg = nM * nN; G = G_; c = c_; }
    __device__ bool next(int i, Unit& u) const {
        const long L = (long)i * G + c; if (L >= nwg) return false;
        int wgid = (int)L; { const int q = nwg / NXCD, r = nwg % NXCD, xcd = wgid % NXCD, off = wgid / NXCD; wgid = (xcd < r ? xcd * (q + 1) : r * (q + 1) + (xcd - r) * q) + off; }
        const int nig = WGM * nN, gid = wgid / nig, fm = gid * WGM, gsz = (nM - fm) < WGM ? (nM - fm) : WGM;
        u.pm = fm + ((wgid % nig) % gsz); u.pn = (wgid % nig) / gsz; return true;
    }
};
struct SingleOrder {
    int pm;
    __device__ bool next(int i, Unit& u) const { if (i != 0) return false; u.pm = pm; u.pn = 0; return true; }
};

template <class Epi, class Sched>
__device__ __forceinline__ void gemm_phase(LAS unsigned char* lds, const Gemm g, const Sched& S, const Epi& E) {
    int tid_ = threadIdx.x; asm volatile("" : "+v"(tid_));
    const int tid = tid_, wid = __builtin_amdgcn_readfirstlane(tid >> 6), lane = tid & 63, wr = wid >> 2, wc = wid & 3, fr = lane & 15, fq = lane >> 4;
    const int K = g.K, nt = K / BK;
    unsigned voffA[2], voffB[2];
#pragma unroll
    for (int i = 0; i < 2; ++i) { int R, C; stage_rc(tid * 16 + i * 8192, R, C);
        const int Rb = (R & ~31) + perm32(R & 31);
        voffA[i] = (unsigned)(R * g.lda + C) * 2u; voffB[i] = (unsigned)(Rb * g.ldb + C) * 2u; }
    const size_t kstep = (size_t)(BK * 2);
    const size_t hstepA = (size_t)HALF * g.lda * 2, hstepB = (size_t)HALF * g.ldb * 2;
    const size_t tstepA = 2 * hstepA, tstepB = 2 * hstepB;
    const unsigned ldsw = (unsigned)wid * 1024u;
    const int aoff = lds_byte(wr * 64 + fr, fq * 8), boff = lds_byte(wc * 32 + fr, fq * 8);
#define PG8_SA(b, h) (((b) * 2 + (h)) * HTB)
#define PG8_SB(b, h) ((4 + (b) * 2 + (h)) * HTB)
#define PG8_STAGE(bufoff, gbase, voff) do { _Pragma("unroll") for (int _i = 0; _i < 2; ++_i) \
        __builtin_amdgcn_global_load_lds((const unsigned*)((const char*)(gbase) + (voff)[_i]), (LAS unsigned*)(lds + (bufoff) + ldsw + _i * 8192), 16, 0, 0); } while (0)
#define PG8_LDA(dst, b, h) do { _Pragma("unroll") for (int m = 0; m < 4; ++m) _Pragma("unroll") for (int k = 0; k < 2; ++k) dst[m][k] = *(const LAS bf16x8*)(lds + PG8_SA(b, h) + aoff + m * 2048 + k * 1024); } while (0)
#define PG8_LDB(dst, b, h) do { _Pragma("unroll") for (int n = 0; n < 2; ++n) _Pragma("unroll") for (int k = 0; k < 2; ++k) dst[n][k] = *(const LAS bf16x8*)(lds + PG8_SB(b, h) + boff + n * 2048 + k * 1024); } while (0)
#define PG8_MMA(ai, bj, At, Bt) do { __builtin_amdgcn_s_setprio(1); _Pragma("unroll") for (int m = 0; m < 4; ++m) _Pragma("unroll") for (int n = 0; n < 2; ++n) _Pragma("unroll") for (int k = 0; k < 2; ++k) \
        acc[ai][bj][m][n] = __builtin_amdgcn_mfma_f32_16x16x32_bf16(Bt[n][k], At[m][k], acc[ai][bj][m][n], 0, 0, 0); __builtin_amdgcn_s_setprio(0); } while (0)
#define PG8_WAIT_V(n) asm volatile("s_waitcnt vmcnt(" #n ")" ::: "memory")
#define PG8_WAIT_L(n) asm volatile("s_waitcnt lgkmcnt(" #n ")" ::: "memory")
#define PG8_BAR __builtin_amdgcn_s_barrier()
#define PG8_SCHED __builtin_amdgcn_sched_barrier(0)
    Unit cur, nxt; int ui = 0;
    if (!S.next(0, cur)) return;
    f32x4 acc[2][2][4][2];
#pragma unroll
    for (int a = 0; a < 2; ++a)
#pragma unroll
        for (int b = 0; b < 2; ++b)
#pragma unroll
            for (int m = 0; m < 4; ++m)
#pragma unroll
                for (int n = 0; n < 2; ++n) acc[a][b][m][n] = (f32x4){0.f, 0.f, 0.f, 0.f};
    bf16x8 At[4][2], B0[2][2], B1[2][2];
    const char* cA = (const char*)g.A + (size_t)cur.pm * tstepA; const char* cB = (const char*)g.Bt + (size_t)cur.pn * tstepB;
    PG8_STAGE(PG8_SB(0, 0), cB, voffB); PG8_STAGE(PG8_SB(0, 1), cB + hstepB, voffB); PG8_STAGE(PG8_SA(0, 0), cA, voffA); PG8_STAGE(PG8_SA(0, 1), cA + hstepA, voffA);
    if (wr == 1) PG8_BAR;
    PG8_WAIT_V(2); PG8_BAR;
    PG8_STAGE(PG8_SB(1, 0), cB + kstep, voffB); PG8_STAGE(PG8_SA(1, 0), cA + kstep, voffA); PG8_STAGE(PG8_SB(1, 1), cB + hstepB + kstep, voffB);
    PG8_WAIT_V(6); PG8_BAR;
    for (;;) {
        const bool has_next = S.next(ui + 1, nxt);
        const char* nA = has_next ? (const char*)g.A + (size_t)nxt.pm * tstepA : cA; const char* nB = has_next ? (const char*)g.Bt + (size_t)nxt.pn * tstepB : cB;
        for (int t = 0; t < nt; t += 2) {
            const bool last = (t == nt - 2);
            const char* a1 = cA + (size_t)(t + 1) * kstep;
            const char* a2 = last ? nA : cA + (size_t)(t + 2) * kstep; const char* b2 = last ? nB : cB + (size_t)(t + 2) * kstep;
            const char* a3 = a2 + kstep; const char* b3 = b2 + kstep;
            PG8_LDB(B0, 0, 0); PG8_LDB(B1, 0, 1); PG8_SCHED; PG8_LDA(At, 0, 0); PG8_STAGE(PG8_SA(1, 1), a1 + hstepA, voffA);
            PG8_WAIT_V(8); PG8_WAIT_L(0); PG8_BAR; PG8_MMA(0, 0, At, B0); PG8_MMA(0, 1, At, B1); PG8_BAR; PG8_SCHED;
            PG8_LDA(At, 0, 1); PG8_STAGE(PG8_SB(0, 0), b2, voffB); PG8_STAGE(PG8_SB(0, 1), b2 + hstepB, voffB); PG8_STAGE(PG8_SA(0, 0), a2, voffA);
            PG8_WAIT_V(8); PG8_WAIT_L(0); PG8_BAR; PG8_MMA(1, 0, At, B0); PG8_MMA(1, 1, At, B1); PG8_BAR; PG8_SCHED;
            PG8_LDB(B0, 1, 0); PG8_LDB(B1, 1, 1); PG8_SCHED; PG8_LDA(At, 1, 0); PG8_STAGE(PG8_SA(0, 1), a2 + hstepA, voffA);
            PG8_WAIT_V(8); PG8_WAIT_L(0); PG8_BAR; PG8_MMA(0, 0, At, B0); PG8_MMA(0, 1, At, B1); PG8_BAR; PG8_SCHED;
            PG8_LDA(At, 1, 1); PG8_STAGE(PG8_SB(1, 0), b3, voffB); PG8_STAGE(PG8_SB(1, 1), b3 + hstepB, voffB); PG8_STAGE(PG8_SA(1, 0), a3, voffA);
            PG8_WAIT_V(8); PG8_WAIT_L(0); PG8_BAR; PG8_MMA(1, 0, At, B0); PG8_MMA(1, 1, At, B1); PG8_BAR; PG8_SCHED;
        }
        if (wr == 0) PG8_BAR;
        E(acc, cur, wr, wc, fr, fq);
        if (!has_next) break;
#pragma unroll
        for (int a = 0; a < 2; ++a)
#pragma unroll
            for (int b = 0; b < 2; ++b)
#pragma unroll
                for (int m = 0; m < 4; ++m)
#pragma unroll
                    for (int n = 0; n < 2; ++n) acc[a][b][m][n] = (f32x4){0.f, 0.f, 0.f, 0.f};
        cur = nxt; cA = nA; cB = nB; ++ui;
        if (wr == 1) PG8_BAR;
    }
    PG8_WAIT_V(0);
    PG8_BAR;
#undef PG8_SA
#undef PG8_SB
#undef PG8_STAGE
#undef PG8_LDA
#undef PG8_LDB
#undef PG8_MMA
#undef PG8_WAIT_V
#undef PG8_WAIT_L
#undef PG8_BAR
#undef PG8_SCHED
}
}

typedef f32x4 Acc[2][2][4][2];

struct EpiProj {
    bf16_t* projq; bf16_t* kva; bf16_t* kvs; bf16_t* craw;
    __device__ __forceinline__ void operator()(const Acc& acc, const pg8::Unit& u, int wr, int wc, int fr, int fq) const {
        const int pn = u.pn;
        bf16_t* base; long SJ, SB, ST;
        if (pn < 4)       { base = projq + pn * 256;                                   SJ = 128; SB = (long)4096 * NQ; ST = NQ; }
        else if (pn < 8)  { base = kva + (size_t)((pn - 4) * 2) * 4096 * 128;          SJ = (long)4096 * 128; SB = (long)8 * 4096 * 128; ST = 128; }
        else if (pn < 12) { base = kva + (size_t)4 * 8 * 4096 * 128 + (size_t)((pn - 8) * 2) * 4096 * 128; SJ = (long)4096 * 128; SB = (long)8 * 4096 * 128; ST = 128; }
        else if (pn < 16) { base = projq + 1024 + (pn - 12) * 256;                     SJ = 128; SB = (long)4096 * NQ; ST = NQ; }
        else if (pn < 18) { base = craw + (size_t)(pn - 16) * (8 * 4096 * 128);        SJ = (long)4096 * 128; SB = (long)2 * 4096 * 128; ST = 128; }
        else if (pn < 22) { base = kvs + (size_t)(pn - 18) * (4 * 2 * 4096 * 128);     SJ = (long)4096 * 128; SB = (long)2 * 4096 * 128; ST = 128; }
        else              { base = projq + 2048;                                       SJ = 128; SB = (long)4096 * NQ; ST = NQ; }
        const int row0 = u.pm * 256 + wr * 64 + fr;
        bf16_t* lanep = base + (long)(row0 >> 12) * SB + (long)(row0 & 4095) * ST + wc * 32 + fq * 8;
#pragma unroll
        for (int ai = 0; ai < 2; ++ai)
#pragma unroll
            for (int m = 0; m < 4; ++m) {
                bf16_t* rowp = lanep + (long)(ai * 128 + m * 16) * ST;
#pragma unroll
                for (int bj = 0; bj < 2; ++bj) {
                    const f32x4 v0 = acc[ai][bj][m][0], v1 = acc[ai][bj][m][1];
                    u32x4 w; w.x = cvt_pk_bf16(v0[0], v0[1]); w.y = cvt_pk_bf16(v0[2], v0[3]); w.z = cvt_pk_bf16(v1[0], v1[1]); w.w = cvt_pk_bf16(v1[2], v1[3]);
                    *(u32x4*)(rowp + bj * SJ) = w;
                }
            }
    }
};
struct EpiHid {
    bf16_t* hid; const float* bias;
    __device__ __forceinline__ void operator()(const Acc& acc, const pg8::Unit& u, int wr, int wc, int fr, int fq) const {
#pragma unroll
        for (int bj = 0; bj < 2; ++bj)
#pragma unroll
            for (int n = 0; n < 2; ++n) {
                const int col = bj * 128 + wc * 32 + fq * 8 + n * 4;
                const f32x4 bv = *(const f32x4*)(bias + col);
#pragma unroll
                for (int ai = 0; ai < 2; ++ai)
#pragma unroll
                    for (int m = 0; m < 4; ++m) {
                        const int row = ai * 128 + wr * 64 + m * 16 + fr;
                        f32x4 v = acc[ai][bj][m][n] + bv;
#pragma unroll
                        for (int j = 0; j < 4; ++j) v[j] = v[j] * __builtin_amdgcn_rcpf(1.f + __expf(-v[j]));
                        u32x2 w; w.x = cvt_pk_bf16(v[0], v[1]); w.y = cvt_pk_bf16(v[2], v[3]);
                        *(u32x2*)(hid + (size_t)row * 256 + col) = w;
                    }
            }
    }
};
struct EpiWout {
    const float* x; bf16_t* hb; float* rsq;
    __device__ __forceinline__ void operator()(const Acc& acc, const pg8::Unit& u, int wr, int wc, int fr, int fq) const {
#pragma unroll
        for (int ai = 0; ai < 2; ++ai)
#pragma unroll
            for (int m = 0; m < 4; ++m) {
                const int row = u.pm * 256 + ai * 128 + wr * 64 + m * 16 + fr;
                float ss = 0.f;
#pragma unroll
                for (int bj = 0; bj < 2; ++bj) {
                    const size_t off = (size_t)row * DM + u.pn * 256 + bj * 128 + wc * 32 + fq * 8;
                    const f32x4 h0 = *(const f32x4*)(x + off) + acc[ai][bj][m][0], h1 = *(const f32x4*)(x + off + 4) + acc[ai][bj][m][1];
                    u32x4 w; w.x = cvt_pk_bf16(h0[0], h0[1]); w.y = cvt_pk_bf16(h0[2], h0[3]); w.z = cvt_pk_bf16(h1[0], h1[1]); w.w = cvt_pk_bf16(h1[2], h1[3]);
                    *(u32x4*)(hb + off) = w;
                    ss += (h0[0] * h0[0] + h0[1] * h0[1]) + (h0[2] * h0[2] + h0[3] * h0[3]) + (h1[0] * h1[0] + h1[1] * h1[1]) + (h1[2] * h1[2] + h1[3] * h1[3]);
                }
                ss += __shfl_xor(ss, 16); ss += __shfl_xor(ss, 32);
                if (fq == 0) atomicAdd(rsq + row, ss);
            }
    }
};
struct EpiSwiglu {
    bf16_t* act; const float* rsq;
    __device__ __forceinline__ void operator()(const Acc& acc, const pg8::Unit& u, int wr, int wc, int fr, int fq) const {
#pragma unroll
        for (int ai = 0; ai < 2; ++ai)
#pragma unroll
            for (int m = 0; m < 4; ++m) {
                const int row = u.pm * 256 + ai * 128 + wr * 64 + m * 16 + fr;
                const float r = rsqrtf(rsq[row] * (1.f / DM) + EPS);
                u32x4 w;
#pragma unroll
                for (int n = 0; n < 2; ++n) {
                    const f32x4 g = acc[ai][0][m][n] * r, up = acc[ai][1][m][n] * r;
                    f32x4 a;
#pragma unroll
                    for (int j = 0; j < 4; ++j) a[j] = g[j] * __builtin_amdgcn_rcpf(1.f + __expf(-g[j])) * up[j];
                    w[2 * n] = cvt_pk_bf16(a[0], a[1]); w[2 * n + 1] = cvt_pk_bf16(a[2], a[3]);
                }
                *(u32x4*)(act + (size_t)row * FF + u.pn * 128 + wc * 32 + fq * 8) = w;
            }
    }
};
struct EpiDown {
    const bf16_t* hb; bf16_t* out; float* rsq;
    __device__ __forceinline__ void operator()(const Acc& acc, const pg8::Unit& u, int wr, int wc, int fr, int fq) const {
#pragma unroll
        for (int ai = 0; ai < 2; ++ai)
#pragma unroll
            for (int m = 0; m < 4; ++m) {
                const int row = u.pm * 256 + ai * 128 + wr * 64 + m * 16 + fr;
                float ss = 0.f;
#pragma unroll
                for (int bj = 0; bj < 2; ++bj) {
                    const size_t off = (size_t)row * DM + u.pn * 256 + bj * 128 + wc * 32 + fq * 8;
                    const u32x4 hw = *(const u32x4*)(hb + off);
                    f32x4 y0 = acc[ai][bj][m][0], y1 = acc[ai][bj][m][1];
                    y0[0] += bf_lo(hw.x); y0[1] += bf_hi(hw.x); y0[2] += bf_lo(hw.y); y0[3] += bf_hi(hw.y);
                    y1[0] += bf_lo(hw.z); y1[1] += bf_hi(hw.z); y1[2] += bf_lo(hw.w); y1[3] += bf_hi(hw.w);
                    { u32x4 w; w.x = cvt_pk_bf16(y0[0], y0[1]); w.y = cvt_pk_bf16(y0[2], y0[3]); w.z = cvt_pk_bf16(y1[0], y1[1]); w.w = cvt_pk_bf16(y1[2], y1[3]); *(u32x4*)(out + off) = w; }
                    ss += (y0[0] * y0[0] + y0[1] * y0[1]) + (y0[2] * y0[2] + y0[3] * y0[3]) + (y1[0] * y1[0] + y1[1] * y1[1]) + (y1[2] * y1[2] + y1[3] * y1[3]);
                }
                ss += __shfl_xor(ss, 16); ss += __shfl_xor(ss, 32);
                if (fq == 0) atomicAdd(rsq + row, ss);
            }
    }
};

constexpr int KP = 136, VPN = 144;
constexpr int LDS_K = 0, LDS_V = 64 * KP * 2;
constexpr int LDS_SCO = 36864;
constexpr int LDS_WU = LDS_SCO + 8 * 2048;

struct Stage { u32x4 k0, k1, v0, v1; };
__device__ __forceinline__ void stage_load(Stage& st, const bf16_t* kb, const bf16_t* vb, long pitch, int tid) {
    const int p0 = tid, p1 = tid + 512;
    st.k0 = *(const u32x4*)(kb + (long)(p0 >> 4) * pitch + (p0 & 15) * 8);
    st.k1 = *(const u32x4*)(kb + (long)(p1 >> 4) * pitch + (p1 & 15) * 8);
    st.v0 = *(const u32x4*)(vb + (long)(p0 >> 4) * pitch + (p0 & 15) * 8);
    st.v1 = *(const u32x4*)(vb + (long)(p1 >> 4) * pitch + (p1 & 15) * 8);
}
__device__ __forceinline__ void stage_load_k(Stage& st, const bf16_t* kb, long pitch, int tid) {
    const int p0 = tid, p1 = tid + 512;
    st.k0 = *(const u32x4*)(kb + (long)(p0 >> 4) * pitch + (p0 & 15) * 8);
    st.k1 = *(const u32x4*)(kb + (long)(p1 >> 4) * pitch + (p1 & 15) * 8);
}
__device__ __forceinline__ void stage_store_k(const Stage& st, LAS unsigned char* lds, int tid) {
    const int p0 = tid, p1 = tid + 512;
    *(LAS u32x4*)(lds + LDS_K + (p0 >> 4) * (KP * 2) + (p0 & 15) * 16) = st.k0;
    *(LAS u32x4*)(lds + LDS_K + (p1 >> 4) * (KP * 2) + (p1 & 15) * 16) = st.k1;
}
__device__ __forceinline__ void stage_store(const Stage& st, LAS unsigned char* lds, int tid) {
    const int p0 = tid, p1 = tid + 512;
    *(LAS u32x4*)(lds + LDS_K + (p0 >> 4) * (KP * 2) + (p0 & 15) * 16) = st.k0;
    *(LAS u32x4*)(lds + LDS_K + (p1 >> 4) * (KP * 2) + (p1 & 15) * 16) = st.k1;
    *(LAS u32x4*)(lds + LDS_V + (p0 >> 4) * (VPN * 2) + (p0 & 15) * 16) = st.v0;
    *(LAS u32x4*)(lds + LDS_V + (p1 >> 4) * (VPN * 2) + (p1 & 15) * 16) = st.v1;
}
template <int NRG>
__device__ __forceinline__ void qk_tile(LAS unsigned char* lds, const bf16x8 (&qf)[NRG][4], f32x4 (&sc)[NRG][4], int fr, int fq) {
#pragma unroll
    for (int s = 0; s < 4; ++s) {
#pragma unroll
        for (int rg = 0; rg < NRG; ++rg) sc[rg][s] = (f32x4){0.f, 0.f, 0.f, 0.f};
#pragma unroll
        for (int kk = 0; kk < 4; ++kk) {
            const bf16x8 kf = *(const LAS bf16x8*)(lds + LDS_K + (s * 16 + fr) * (KP * 2) + kk * 64 + fq * 16);
#pragma unroll
            for (int rg = 0; rg < NRG; ++rg) sc[rg][s] = __builtin_amdgcn_mfma_f32_16x16x32_bf16(kf, qf[rg][kk], sc[rg][s], 0, 0, 0);
        }
    }
}
typedef short s16x4 __attribute__((ext_vector_type(4)));
template <int NRG>
__device__ __forceinline__ void pv_tile(LAS unsigned char* lds, const bf16x8 (&pb)[NRG][2], f32x4 (&o)[NRG][8], int fr, int fq) {
    LAS unsigned char* vbase = lds + LDS_V + (4 * fq + (fr >> 2)) * (VPN * 2) + (fr & 3) * 8;
#pragma unroll
    for (int c = 0; c < 8; ++c)
#pragma unroll
        for (int u = 0; u < 2; ++u) {
            const s16x4 lo = __builtin_amdgcn_ds_read_tr16_b64_v4i16((LAS s16x4*)(vbase + (32 * u) * (VPN * 2) + c * 32));
            const s16x4 hi = __builtin_amdgcn_ds_read_tr16_b64_v4i16((LAS s16x4*)(vbase + (32 * u + 16) * (VPN * 2) + c * 32));
            const bf16x8 vf = {lo[0], lo[1], lo[2], lo[3], hi[0], hi[1], hi[2], hi[3]};
#pragma unroll
            for (int rg = 0; rg < NRG; ++rg) o[rg][c] = __builtin_amdgcn_mfma_f32_16x16x32_bf16(vf, pb[rg][u], o[rg][c], 0, 0, 0);
        }
}
__device__ __forceinline__ bf16x8 pack8(const f32x4 a, const f32x4 b) {
    u32x4 w = {cvt_pk_bf16(a[0], a[1]), cvt_pk_bf16(a[2], a[3]), cvt_pk_bf16(b[0], b[1]), cvt_pk_bf16(b[2], b[3])};
    return *reinterpret_cast<bf16x8*>(&w);
}
__device__ __forceinline__ void softmax_update(f32x4 (&x)[4], float& m, float& l, f32x4 (&o)[8], bf16x8 (&pb)[2]) {
    float mx = x[0][0];
#pragma unroll
    for (int s = 0; s < 4; ++s)
#pragma unroll
        for (int r = 0; r < 4; ++r) mx = fmaxf(mx, x[s][r]);
    mx = fmaxf(mx, __shfl_xor(mx, 16)); mx = fmaxf(mx, __shfl_xor(mx, 32));
    const float mn = fmaxf(m, mx);
    const float alpha = __builtin_amdgcn_exp2f(m - mn);
    m = mn;
    float ls = 0.f;
#pragma unroll
    for (int s = 0; s < 4; ++s)
#pragma unroll
        for (int r = 0; r < 4; ++r) { x[s][r] = __builtin_amdgcn_exp2f(x[s][r] - mn); ls += x[s][r]; }
    l = l * alpha + ls;
#pragma unroll
    for (int c = 0; c < 8; ++c) o[c] *= alpha;
    pb[0] = pack8(x[0], x[1]); pb[1] = pack8(x[2], x[3]);
}
template <bool MASK>
__device__ __forceinline__ void softmax_tile(f32x4 (&x)[4], float slope2, float base, int relb, unsigned W, float& m, float& l, f32x4 (&o)[8], bf16x8 (&pb)[2]) {
    float mx = -__builtin_inff();
#pragma unroll
    for (int s = 0; s < 4; ++s)
#pragma unroll
        for (int r = 0; r < 4; ++r) {
            const int k = 16 * s + r;
            float y = fmaf(x[s][r], C2, fmaf(slope2, (float)k, base));
            if (MASK) y = ((unsigned)(relb - k) <= W) ? y : -__builtin_inff();
            x[s][r] = y; mx = fmaxf(mx, y);
        }
    mx = fmaxf(mx, __shfl_xor(mx, 16)); mx = fmaxf(mx, __shfl_xor(mx, 32));
    float mn = m;
    if (!__all(mx - m <= 8.f)) {
        mn = fmaxf(m, mx);
        const float alpha = __builtin_amdgcn_exp2f(m - mn);
        m = mn; l *= alpha;
#pragma unroll
        for (int c = 0; c < 8; ++c) o[c] *= alpha;
    }
    float ls = 0.f;
#pragma unroll
    for (int s = 0; s < 4; ++s)
#pragma unroll
        for (int r = 0; r < 4; ++r) { x[s][r] = __builtin_amdgcn_exp2f(x[s][r] - mn); ls += x[s][r]; }
    l += ls;
    pb[0] = pack8(x[0], x[1]); pb[1] = pack8(x[2], x[3]);
}
__device__ __forceinline__ void store_o_row(bf16_t* dst, const f32x4 (&o)[8], float inv, int fq) {
#pragma unroll
    for (int c = 0; c < 8; ++c) {
        u32x2 w; w.x = cvt_pk_bf16(o[c][0] * inv, o[c][1] * inv); w.y = cvt_pk_bf16(o[c][2] * inv, o[c][3] * inv);
        *(u32x2*)(dst + c * 16 + fq * 4) = w;
    }
}

__device__ __forceinline__ void band_job(LAS unsigned char* lds, const bf16_t* qb, long qpitch, const bf16_t* kb, const bf16_t* vb, long kvpitch,
                                         int q0, int W, float slope2, bf16_t* ob, long opitch, float* lseb, long lsepitch) {
    int tid_ = threadIdx.x; asm volatile("" : "+v"(tid_));
    const int tid = tid_, wid = __builtin_amdgcn_readfirstlane(tid >> 6), lane = tid & 63, fr = lane & 15, fq = lane >> 4;
    bf16x8 qf[2][4]; f32x4 o[2][8]; float m[2], l[2]; int qi[2];
#pragma unroll
    for (int rg = 0; rg < 2; ++rg) {
        qi[rg] = q0 + wid * 32 + rg * 16 + fr;
#pragma unroll
        for (int kk = 0; kk < 4; ++kk) qf[rg][kk] = *(const bf16x8*)(qb + (long)qi[rg] * qpitch + kk * 32 + fq * 8);
#pragma unroll
        for (int c = 0; c < 8; ++c) o[rg][c] = (f32x4){0.f, 0.f, 0.f, 0.f};
        m[rg] = -1e30f; l[rg] = 0.f;
    }
    const int qa = q0 + wid * 32;
    const int kt_lo = (q0 - W > 0 ? q0 - W : 0) >> 6, kt_hi = (q0 + 255) >> 6;
    Stage st; stage_load(st, kb + (long)(kt_lo * 64) * kvpitch, vb + (long)(kt_lo * 64) * kvpitch, kvpitch, tid);
    for (int kt = kt_lo; kt <= kt_hi; ++kt) {
        __syncthreads();
        stage_store(st, lds, tid);
        __syncthreads();
        if (kt < kt_hi) stage_load(st, kb + (long)((kt + 1) * 64) * kvpitch, vb + (long)((kt + 1) * 64) * kvpitch, kvpitch, tid);
        const bool need = (kt * 64 <= qa + 31) && (kt * 64 + 63 >= qa - W);
        if (need) {
            bf16x8 pb[2][2]; f32x4 sc[2][4];
            qk_tile<2>(lds, qf, sc, fr, fq);
#pragma unroll
            for (int rg = 0; rg < 2; ++rg) {
                const int relb = qi[rg] - kt * 64 - fq * 4;
                const float base = -slope2 * (float)relb;
                softmax_tile<true>(sc[rg], slope2, base, relb, (unsigned)W, m[rg], l[rg], o[rg], pb[rg]);
            }
            pv_tile<2>(lds, pb, o, fr, fq);
        }
    }
#pragma unroll
    for (int rg = 0; rg < 2; ++rg) {
        float lt = l[rg]; lt += __shfl_xor(lt, 16); lt += __shfl_xor(lt, 32);
        const float inv = lt > 0.f ? 1.f / lt : 0.f;
        store_o_row(ob + (long)qi[rg] * opitch, o[rg], inv, fq);
        if (lseb && fq == 0) lseb[(long)qi[rg] * lsepitch] = (m[rg] + __log2f(lt)) * LN2;
    }
}

__device__ __forceinline__ void nsa_job(LAS unsigned char* lds, const bf16_t* proj, const bf16_t* ksv, const bf16_t* kc, const bf16_t* vc, bf16_t* ocmp, bf16_t* osel, int b, int g, int chunk, int half, bool dry = false) {
    int tid_ = threadIdx.x; asm volatile("" : "+v"(tid_));
    const int tid = tid_, wid = __builtin_amdgcn_readfirstlane(tid >> 6), lane = tid & 63, fr = lane & 15, fq = lane >> 4;
    const int t0 = chunk * 64, tq = t0 + half * 32 + wid * 4 + (fr & 3);
    const int head = fr >> 2, hq = g * 4 + head;
    const size_t rowbase = (size_t)(b * S_ + tq);
    const float slope2 = __builtin_amdgcn_exp2f(-(float)(hq + 1)) * LOG2E;
    bf16x8 qf[1][4]; f32x4 o[1][8]; float m = -1e30f, l = 0.f;
#pragma unroll
    for (int kk = 0; kk < 4; ++kk) qf[0][kk] = *(const bf16x8*)(proj + rowbase * NQ + 1024 + hq * 128 + kk * 32 + fq * 8);
    const bf16_t* kcb = kc + (size_t)(b * 2 + g) * 256 * 128; const bf16_t* vcb = vc + (size_t)(b * 2 + g) * 256 * 128;
    const int cmax = (t0 + 32) >> 4;
    const int ktc = (cmax >> 6) > 3 ? 3 : (cmax >> 6);
    Stage stA, stB;
    float imp[16];
#pragma unroll
    for (int i = 0; i < 16; ++i) imp[i] = 0.f;
#pragma unroll
    for (int c = 0; c < 8; ++c) o[0][c] = (f32x4){0.f, 0.f, 0.f, 0.f};
    {
        stage_load(stA, kcb, vcb, 128, tid);
        if (ktc >= 1) stage_load(stB, kcb + (size_t)64 * 128, vcb + (size_t)64 * 128, 128, tid);
#pragma unroll
        for (int kt = 0; kt < 4; ++kt) {
            if (kt <= ktc) {
                __syncthreads(); stage_store((kt & 1) ? stB : stA, lds, tid); __syncthreads();
                if (kt + 2 <= ktc) stage_load((kt & 1) ? stB : stA, kcb + (size_t)(kt + 2) * 64 * 128, vcb + (size_t)(kt + 2) * 64 * 128, 128, tid);
                f32x4 sc[1][4]; bf16x8 pb[1][2];
                qk_tile<1>(lds, qf, sc, fr, fq);
                const int relb = tq - 31 - 16 * (kt * 64 + fq * 4);
                float mx = -__builtin_inff();
#pragma unroll
                for (int s = 0; s < 4; ++s)
#pragma unroll
                    for (int r = 0; r < 4; ++r) {
                        const int rel = relb - 256 * s - 16 * r;
                        const float v = sc[0][s][r] * C2 - slope2 * (float)rel;
                        sc[0][s][r] = (rel >= 0) ? v : -__builtin_inff();
                        mx = fmaxf(mx, sc[0][s][r]);
                    }
                mx = fmaxf(mx, __shfl_xor(mx, 16)); mx = fmaxf(mx, __shfl_xor(mx, 32));
                const float mn = fmaxf(m, mx);
                const float alpha = __builtin_amdgcn_exp2f(m - mn);
                m = mn; l *= alpha;
#pragma unroll
                for (int c = 0; c < 8; ++c) o[0][c] *= alpha;
#pragma unroll
                for (int i = 0; i < 16; ++i) imp[i] *= alpha;
                float ls = 0.f;
#pragma unroll
                for (int s = 0; s < 4; ++s) {
#pragma unroll
                    for (int r = 0; r < 4; ++r) { sc[0][s][r] = __builtin_amdgcn_exp2f(sc[0][s][r] - mn); ls += sc[0][s][r]; }
                    const float own = (sc[0][s][0] + sc[0][s][1]) + (sc[0][s][2] + sc[0][s][3]);
                    const float recv = __shfl(sc[0][s][3], (lane - 16) & 63);
                    imp[kt * 4 + s] += own + (fq != 0 ? recv : 0.f);
                    if (kt * 4 + s + 1 < 16) imp[kt * 4 + s + 1] += (fq != 0 ? 0.f : recv);
                }
                l += ls;
                pb[0][0] = pack8(sc[0][0], sc[0][1]); pb[0][1] = pack8(sc[0][2], sc[0][3]);
                pv_tile<1>(lds, pb, o, fr, fq);
            }
        }
    }
    {
        float lt = l; lt += __shfl_xor(lt, 16); lt += __shfl_xor(lt, 32);
        const float inv = lt > 0.f ? 1.f / lt : 0.f;
#pragma unroll
        for (int i = 0; i < 16; ++i) imp[i] *= inv;
        if (!dry) store_o_row(ocmp + rowbase * 1024 + hq * 128, o[0], inv, fq);
    }
    float sco[16];
    LAS float* scw = (LAS float*)(lds + LDS_SCO + wid * 1024) + (fr & 3) * 64;
#pragma unroll
    for (int i = 0; i < 16; ++i) {
        float tot = imp[i] + __shfl_xor(imp[i], 4);
        tot = tot + __shfl_xor(tot, 8);
        const int n = 4 * i + fq;
        const bool valid = n <= chunk;
        const bool forced = (n == 0) || (valid && n > chunk - 2);
        sco[i] = valid ? tot + (forced ? 1000.f : 0.f) : -1.f;
        scw[n] = sco[i];
    }
    asm volatile("s_waitcnt lgkmcnt(0)" ::: "memory");
    int rank[16];
#pragma unroll
    for (int i = 0; i < 16; ++i) rank[i] = 0;
    for (int j = 0; j < 16; ++j) {
        const int n2 = head * 16 + j;
        const float v2 = scw[n2];
#pragma unroll
        for (int i = 0; i < 16; ++i) {
            const int n = 4 * i + fq;
            rank[i] += ((v2 > sco[i]) || (v2 == sco[i] && n2 < n)) ? 1 : 0;
        }
    }
    unsigned mlo = 0u, mhi = 0u;
#pragma unroll
    for (int i = 0; i < 16; ++i) {
        int rk = rank[i] + __shfl_xor(rank[i], 4);
        rk = rk + __shfl_xor(rk, 8);
        const int n = 4 * i + fq;
        const bool sel = (n <= chunk) && rk < 16;
        if (i < 8) mlo |= sel ? (1u << (n & 31)) : 0u; else mhi |= sel ? (1u << (n & 31)) : 0u;
    }
    mlo |= __shfl_xor(mlo, 16); mlo |= __shfl_xor(mlo, 32); mhi |= __shfl_xor(mhi, 16); mhi |= __shfl_xor(mhi, 32);
    unsigned wlo = mlo, whi = mhi;
#pragma unroll
    for (int x = 1; x < 4; x <<= 1) { wlo |= __shfl_xor(wlo, x); whi |= __shfl_xor(whi, x); }
    wlo = __builtin_amdgcn_readfirstlane(wlo); whi = __builtin_amdgcn_readfirstlane(whi);
    LAS unsigned* wu = (LAS unsigned*)(lds + LDS_WU);
    if (lane == 0) { wu[wid * 2] = wlo; wu[wid * 2 + 1] = whi; }
    __syncthreads();
    unsigned ulo = 0u, uhi = 0u;
#pragma unroll
    for (int w = 0; w < 8; ++w) { ulo |= wu[w * 2]; uhi |= wu[w * 2 + 1]; }
    ulo = __builtin_amdgcn_readfirstlane(ulo); uhi = __builtin_amdgcn_readfirstlane(uhi);
    const unsigned long long mymask = ((unsigned long long)mhi << 32) | mlo;
    const unsigned long long wmask = ((unsigned long long)whi << 32) | wlo;
    unsigned long long rem = ((unsigned long long)uhi << 32) | ulo;
    m = -1e30f; l = 0.f;
#pragma unroll
    for (int c = 0; c < 8; ++c) o[0][c] = (f32x4){0.f, 0.f, 0.f, 0.f};
    const bf16_t* ksb = ksv + (size_t)(b * 2 + g) * 4096 * 128; const bf16_t* vsb = ksv + (size_t)4 * 2 * 4096 * 128 + (size_t)(b * 2 + g) * 4096 * 128;
#define NSA_POP(var) do { if (rem != 0ull) { var = __builtin_ctzll(rem); rem &= rem - 1; } else var = -1; } while (0)
#define NSA_SEL_COMPUTE(n) do { if (!dry && ((wmask >> (n)) & 1ull)) { \
        f32x4 sc[1][4]; bf16x8 pb[1][2]; \
        qk_tile<1>(lds, qf, sc, fr, fq); \
        const bool mysel = (mymask >> (n)) & 1ull; \
        const int relb = tq - (n) * 64 - fq * 4; \
        const float base = mysel ? -slope2 * (float)relb : -__builtin_inff(); \
        if ((n) < chunk) softmax_tile<false>(sc[0], slope2, base, relb, 0x7fffffffu, m, l, o[0], pb[0]); \
        else softmax_tile<true>(sc[0], slope2, base, relb, 0x7fffffffu, m, l, o[0], pb[0]); \
        pv_tile<1>(lds, pb, o, fr, fq); } } while (0)
    {
        int na, nb, nc, nd;
        NSA_POP(na); NSA_POP(nb);
        stage_load(stA, ksb + (size_t)(na * 64) * 128, vsb + (size_t)(na * 64) * 128, 128, tid);
        if (nb >= 0) stage_load(stB, ksb + (size_t)(nb * 64) * 128, vsb + (size_t)(nb * 64) * 128, 128, tid);
        for (;;) {
            __syncthreads(); stage_store(stA, lds, tid); __syncthreads();
            NSA_POP(nc);
            if (nc >= 0) stage_load(stA, ksb + (size_t)(nc * 64) * 128, vsb + (size_t)(nc * 64) * 128, 128, tid);
            NSA_SEL_COMPUTE(na);
            if (nb < 0) break;
            __syncthreads(); stage_store(stB, lds, tid); __syncthreads();
            NSA_POP(nd);
            if (nd >= 0) stage_load(stB, ksb + (size_t)(nd * 64) * 128, vsb + (size_t)(nd * 64) * 128, 128, tid);
            NSA_SEL_COMPUTE(nb);
            if (nc < 0) break;
            na = nc; nb = nd;
        }
    }
#undef NSA_POP
#undef NSA_SEL_COMPUTE
    {
        float lt = l; lt += __shfl_xor(lt, 16); lt += __shfl_xor(lt, 32);
        const float iv = lt > 0.f ? 1.f / lt : 0.f;
        if (!dry) store_o_row(osel + rowbase * 1024 + hq * 128, o[0], iv, fq);
    }
}

__device__ __forceinline__ void transpose_item(const float* W, int K, int N, bf16_t* WT, int item, int nblk, LAS float* scr, int lane, const float* gk, int mode, int off) {
    const int kb = item / nblk, nb = item % nblk, k0 = 64 * kb, n0 = 32 * nb;
    const int nn = n0 + (lane & 31);
    const bool nok = nn < N;
    float v[32];
#pragma unroll
    for (int i = 0; i < 32; ++i) v[i] = nok ? __builtin_nontemporal_load(W + (size_t)(k0 + 2 * i + (lane >> 5)) * N + nn) : 0.f;
    if (gk) {
#pragma unroll
        for (int i = 0; i < 32; ++i) v[i] *= gk[k0 + 2 * i + (lane >> 5)];
    }
#pragma unroll
    for (int i = 0; i < 32; ++i) scr[(2 * i + (lane >> 5)) * 33 + (lane & 31)] = v[i];
    asm volatile("s_waitcnt lgkmcnt(0)" ::: "memory");
    const int c = lane & 7;
#pragma unroll
    for (int j = 0; j < 4; ++j) {
        const int n = (lane >> 3) + 8 * j; const LAS float* s = scr + (8 * c) * 33 + n;
        u32x4 ov; ov.x = cvt_pk_bf16(s[0 * 33], s[1 * 33]); ov.y = cvt_pk_bf16(s[2 * 33], s[3 * 33]); ov.z = cvt_pk_bf16(s[4 * 33], s[5 * 33]); ov.w = cvt_pk_bf16(s[6 * 33], s[7 * 33]);
        const int ng = n0 + n;
        const int row = mode ? ((ng >> 7) * 256 + (ng & 127) + off) : ng;
        *(u32x4*)(WT + (size_t)row * K + k0 + 8 * c) = ov;
    }
    asm volatile("s_waitcnt lgkmcnt(0)" ::: "memory");
}

__device__ __forceinline__ void grid_barrier(unsigned* bar, unsigned target) {
    asm volatile("s_waitcnt vmcnt(0) lgkmcnt(0)" ::: "memory");
    __syncthreads();
    if (threadIdx.x == 0) {
        __builtin_amdgcn_fence(__ATOMIC_RELEASE, "agent");
        asm volatile("s_waitcnt vmcnt(0)" ::: "memory");
        __hip_atomic_fetch_add(bar, 1u, __ATOMIC_RELAXED, __HIP_MEMORY_SCOPE_AGENT);
        while (__hip_atomic_load(bar, __ATOMIC_RELAXED, __HIP_MEMORY_SCOPE_AGENT) < target) __builtin_amdgcn_s_sleep(1);
        __builtin_amdgcn_fence(__ATOMIC_ACQUIRE, "agent");
        asm volatile("s_waitcnt vmcnt(0)" ::: "memory");
    }
    __syncthreads();
}
#define GRID_SYNC() do { ++nbar; grid_barrier((unsigned*)(p.ws + WS_BAR), nbar * (unsigned)G); } while (0)
struct Params {
    const float* x; const float* norm1_g; const float* w_in;
    const float* pe_k; const float* w1_k; const float* w2_k; const float* pe_v; const float* w1_v; const float* w2_v;
    const float* gn_a; const float* gn_b; const float* w_out; const float* norm2_g; const float* w_gate; const float* w_up; const float* w_down; const float* final_g;
    float* out; unsigned char* ws;
};

__global__ void __launch_bounds__(512, 2) fwd_mega(Params p) {
    extern __shared__ __attribute__((aligned(16))) unsigned char lds_raw[];
    LAS unsigned char* lds = (LAS unsigned char*)lds_raw;
    cg::grid_group grid = cg::this_grid();
    const int tid = threadIdx.x, lane = tid & 63, wid = __builtin_amdgcn_readfirstlane(tid >> 6);
    const int G = gridDim.x, bx = blockIdx.x;
    unsigned nbar = 0;
#define ctl ((unsigned*)(p.ws + WS_CTL))
#define rsq2 ((float*)(p.ws + WS_RSQ2))
#define rsq3 ((float*)(p.ws + WS_RSQ3))
#define biasc ((float*)(p.ws + WS_BIASC))
#define biasp ((float*)(p.ws + WS_BIASP))
#define Wt_in ((bf16_t*)(p.ws + WS_WIN))
#define Wt_out ((bf16_t*)(p.ws + WS_WOUT))
#define Wt_gu ((bf16_t*)(p.ws + WS_WGU))
#define Wt_dn ((bf16_t*)(p.ws + WS_WDN))
#define Wt_c1 ((bf16_t*)(p.ws + WS_WC1))
#define W2t ((bf16_t*)(p.ws + WS_W2T))
#define craw ((bf16_t*)(p.ws + WS_CRAW))
#define hid ((bf16_t*)(p.ws + WS_HID))
#define kvc ((bf16_t*)(p.ws + WS_KVC))
#define lse ((float*)(p.ws + WS_LSE))
#define hn ((bf16_t*)(p.ws + WS_R1))
#define mixed ((bf16_t*)(p.ws + WS_R1))
#define proj ((bf16_t*)(p.ws + WS_PROJ))
#define act ((bf16_t*)(p.ws + WS_PROJ))
#define kva ((bf16_t*)(p.ws + WS_KVA))
#define kvs ((bf16_t*)(p.ws + WS_KVS))
#define ob ((bf16_t*)(p.ws + WS_OB))
#define hb ((bf16_t*)(p.ws + WS_OB))
#define oA ((bf16_t*)p.out)
    LAS int* slot = (LAS int*)(lds + LDS_SLOT);

    {
        const int gt = bx * 512 + tid;
        if (gt < T_) { rsq2[gt] = 0.f; rsq3[gt] = 0.f; }
        if (bx == 0 && tid < 16) ctl[tid] = 0u;
        if (bx == 0 && tid == 0) *(unsigned*)(p.ws + WS_BAR) = 0u;
        for (int job = bx; job < 64; job += G) {
            const int which = job >> 5, ks = job & 31;
            const float* pe = which ? p.pe_v : p.pe_k; const float* w1 = which ? p.w1_v : p.w1_k;
            const int n = tid & 255, kh = tid >> 8, kbeg = ks * 128 + kh * 64;
            float a = 0.f;
#pragma unroll 16
            for (int k = 0; k < 64; ++k) a += pe[kbeg + k] * w1[(size_t)(kbeg + k) * 256 + n];
            biasp[(size_t)(which * 64 + ks * 2 + kh) * 256 + n] = a;
        }
        LAS float* scr = (LAS float*)(lds + wid * 8704);
        const int gw = bx * 8 + wid, NGW = G * 8;
        constexpr int I_IN = 32 * 184, I_OUT = 32 * 64, I_G = 32 * 176, I_DN = 88 * 64, I_C1 = 64 * 8, I_W2 = 4 * 4;
        constexpr int NITEMS = I_IN + I_OUT + 2 * I_G + 2 * I_C1 + 2 * I_W2;
        for (int it = gw; it < NITEMS; it += NGW) {
            int r = it;
            if (r < I_IN) { transpose_item(p.w_in, DM, PIN, Wt_in, r, 184, scr, lane, nullptr, 0, 0); continue; } r -= I_IN;
            if (r < I_OUT) { transpose_item(p.w_out, DM, DM, Wt_out, r, 64, scr, lane, nullptr, 0, 0); continue; } r -= I_OUT;
            if (r < I_G) { transpose_item(p.w_gate, DM, FF, Wt_gu, r, 176, scr, lane, p.norm2_g, 1, 0); continue; } r -= I_G;
            if (r < I_G) { transpose_item(p.w_up, DM, FF, Wt_gu, r, 176, scr, lane, p.norm2_g, 1, 128); continue; } r -= I_G;
            if (r < I_C1) { transpose_item(p.w1_k, 4096, 256, Wt_c1, r, 8, scr, lane, nullptr, 0, 0); continue; } r -= I_C1;
            if (r < I_C1) { transpose_item(p.w1_v, 4096, 256, Wt_c1 + 256 * 4096, r, 8, scr, lane, nullptr, 0, 0); continue; } r -= I_C1;
            if (r < I_W2) { transpose_item(p.w2_k, 256, 128, W2t, r, 4, scr, lane, nullptr, 0, 0); continue; } r -= I_W2;
            transpose_item(p.w2_v, 256, 128, W2t + 128 * 256, r, 4, scr, lane, nullptr, 0, 0);
        }
        for (int row = gw; row < T_; row += NGW) {
            const f32x4* xr = (const f32x4*)(p.x + (size_t)row * DM) + lane;
            f32x4 v[8]; float ss = 0.f;
#pragma unroll
            for (int j = 0; j < 8; ++j) { v[j] = __builtin_nontemporal_load(xr + 64 * j); ss += (v[j][0] * v[j][0] + v[j][1] * v[j][1]) + (v[j][2] * v[j][2] + v[j][3] * v[j][3]); }
            const float r = rsqrtf(wave_sum(ss) * (1.f / DM) + EPS);
            u32x2* o8 = (u32x2*)(hn + (size_t)row * DM) + lane;
#pragma unroll
            for (int j = 0; j < 8; ++j) {
                const f32x4 gg = *((const f32x4*)p.norm1_g + lane + 64 * j);
                u32x2 w; w.x = cvt_pk_bf16(v[j][0] * r * gg[0], v[j][1] * r * gg[1]); w.y = cvt_pk_bf16(v[j][2] * r * gg[2], v[j][3] * r * gg[3]);
                o8[64 * j] = w;
            }
        }
    }
    asm volatile("s_waitcnt vmcnt(0) lgkmcnt(0)" ::: "memory");
    grid.sync();
    asm volatile("s_waitcnt vmcnt(0)" ::: "memory");

    if (bx < 2 && tid < 256) {
        float sacc = 0.f;
#pragma unroll 16
        for (int j = 0; j < 64; ++j) sacc += biasp[(size_t)(bx * 64 + j) * 256 + tid];
        biasc[bx * 256 + tid] = sacc;
    }
    {
        pg8::Gemm g{hn, Wt_in, T_, NP, DM, DM, DM}; pg8::StaticOrder S; S.init(T_, NP, G, bx);
        EpiProj E{proj, kva, kvs, craw};
        pg8::gemm_phase<EpiProj, pg8::StaticOrder>(lds, g, S, E);
        const int nunits = (T_ / 256) * (NP / 256), full = nunits / G, rem = nunits - full * G;
        if (rem > 0 && bx >= rem) {
            LAS float* scr = (LAS float*)(lds + wid * 8704);
            const int nidle = G - rem;
            for (int it = (bx - rem) * 8 + wid; it < 88 * 64; it += nidle * 8) transpose_item(p.w_down, FF, DM, Wt_dn, it, 64, scr, lane, nullptr, 0, 0);
        } else if (rem == 0) {
            LAS float* scr = (LAS float*)(lds + wid * 8704);
            for (int it = bx * 8 + wid; it < 88 * 64; it += G * 8) transpose_item(p.w_down, FF, DM, Wt_dn, it, 64, scr, lane, nullptr, 0, 0);
        }
    }
    GRID_SYNC();

    for (int job = bx; job < 16; job += G) {
        {
            const int which = job >> 3, bg = job & 7;
            bf16_t* hd = hid + (size_t)(which * 8 + bg) * 256 * 256;
            pg8::Gemm g{craw + (size_t)which * (8 * 4096 * 128), Wt_c1 + (size_t)which * 256 * 4096, 2048, 256, 4096, 2048, 4096};
            pg8::SingleOrder S{bg};
            EpiHid E{hd, biasc + which * 256};
            pg8::gemm_phase<EpiHid, pg8::SingleOrder>(lds, g, S, E);
        }
        __syncthreads();
    }
    for (;;) {
        __syncthreads();
        if (tid == 0) *slot = (int)atomicAdd(ctl + 0, 1u);
        __syncthreads();
        const int job = *slot;
        if (job >= 512 + 1536) break;
        if (job < 512) {
            const int j = job, qt = j & 15, hh = (j >> 4) & 7, b = j >> 7;
            const float slope2 = __builtin_amdgcn_exp2f(-(float)(hh + 1)) * LOG2E;
            const bf16_t* kwb = kvs + (size_t)2 * 4 * 2 * 4096 * 128 + (size_t)(b * 2 + (hh >> 2)) * 4096 * 128;
            band_job(lds, proj + (size_t)b * S_ * NQ + 1024 + hh * 128, NQ, kwb, kwb + (size_t)4 * 2 * 4096 * 128, 128,
                     qt * 256, 511, slope2, ob + (size_t)2 * T_ * 1024 + (size_t)b * S_ * 1024 + hh * 128, 1024, nullptr, 0);
        } else {
            const int j = job - 512, sub = j & 15, hh = (j >> 4) & 7, b = (j >> 7) & 3, cfg = j >> 9;
            const int dil = cfg == 0 ? 1 : (cfg == 1 ? 4 : 16);
            const int nqt = 16 / dil;
            const int r = sub / nqt, qt = sub % nqt;
            const float slope2 = __builtin_amdgcn_exp2f(-0.5f * (float)(2 * hh + 1)) * (float)dil * LOG2E;
            const bf16_t* kab = kva + ((size_t)(b * 8 + hh) * 4096 + r) * 128;
            band_job(lds, proj + (size_t)(b * S_ + r) * NQ + hh * 128, (long)dil * NQ, kab, kab + (size_t)4 * 8 * 4096 * 128, (long)dil * 128, qt * 256, 128, slope2,
                     oA + (size_t)cfg * T_ * 1024 + (size_t)(b * S_ + r) * 1024 + hh * 128, (long)dil * 1024,
                     lse + (size_t)cfg * T_ * 8 + (size_t)(b * S_ + r) * 8 + hh, (long)dil * 8);
        }
    }
    GRID_SYNC();

    for (int grp = bx; grp < 256; grp += G) {
        const int which = grp >> 7, bg = (grp >> 4) & 7, r0 = (grp & 15) * 16;
        const u32x4* wsrc = (const u32x4*)(W2t + (size_t)which * 128 * 256);
        const u32x4* hsrc = (const u32x4*)(hid + ((size_t)(which * 8 + bg) * 256 + r0) * 256);
        __syncthreads();
        for (int i = tid; i < 4096; i += 512) *(LAS u32x4*)(lds + i * 16) = wsrc[i];
        *(LAS u32x4*)(lds + 65536 + tid * 16) = hsrc[tid];
        __syncthreads();
        const int d = tid & 127, rq = tid >> 7;
        const LAS u32x4* wl = (const LAS u32x4*)(lds + d * 512);
        float acc2[4] = {0.f, 0.f, 0.f, 0.f};
        for (int jb = 0; jb < 32; ++jb) {
            const u32x4 wv = wl[(jb + d) & 31];
            const int jc = (jb + d) & 31;
#pragma unroll
            for (int r = 0; r < 4; ++r) {
                const u32x4 hv = *(const LAS u32x4*)(lds + 65536 + (rq * 4 + r) * 512 + jc * 16);
#pragma unroll
                for (int e = 0; e < 4; ++e) acc2[r] += bf_lo(wv[e]) * bf_lo(hv[e]) + bf_hi(wv[e]) * bf_hi(hv[e]);
            }
        }
        bf16_t* dstb = kvc + ((size_t)(which * 8 + bg) * 256 + r0) * 128;
#pragma unroll
        for (int r = 0; r < 4; ++r) {
            const int c = r0 + rq * 4 + r;
            const unsigned w16 = cvt_pk_bf16(c == 255 ? 0.f : acc2[r], 0.f);
            dstb[(size_t)(rq * 4 + r) * 128 + d] = (bf16_t)(w16 & 0xffffu);
        }
    }
    GRID_SYNC();

    for (;;) {
        __syncthreads();
        if (tid == 0) *slot = (int)atomicAdd(ctl + 1, 1u);
        __syncthreads();
        const int job = *slot;
        if (job >= 1024) break;
        const int chunk = 63 - (job >> 4), bg = job & 7, half = (job >> 3) & 1;
        nsa_job(lds, proj, kvs, kvc, kvc + (size_t)8 * 256 * 128, ob, ob + (size_t)T_ * 1024, bg >> 1, bg & 1, chunk, half);
    }
    GRID_SYNC();

    {
        const int gw = bx * 8 + wid, NGW = G * 8;
        for (int row = gw; row < T_; row += NGW) {
            u32x4 xa[3][2], xb[3][2];
#pragma unroll
            for (int i = 0; i < 3; ++i)
#pragma unroll
                for (int q = 0; q < 2; ++q) {
                    xa[i][q] = __builtin_nontemporal_load((const u32x4*)(oA + (size_t)(i * T_ + row) * 1024 + q * 512 + lane * 8));
                    xb[i][q] = __builtin_nontemporal_load((const u32x4*)(ob + (size_t)(i * T_ + row) * 1024 + q * 512 + lane * 8));
                }
            float o[16]; float ss = 0.f;
#pragma unroll
            for (int q = 0; q < 2; ++q) {
                const int h = q * 4 + (lane >> 4);
                const float l0 = lse[(size_t)row * 8 + h], l1 = lse[(size_t)(T_ + row) * 8 + h], l2 = lse[(size_t)(2 * T_ + row) * 8 + h];
                const float mx = fmaxf(l0, fmaxf(l1, l2));
                float w0 = __expf(l0 - mx), w1 = __expf(l1 - mx), w2 = __expf(l2 - mx);
                const float wi = 1.f / (w0 + w1 + w2); w0 *= wi; w1 *= wi; w2 *= wi;
#pragma unroll
                for (int e = 0; e < 4; ++e) {
                    o[q * 8 + 2 * e] = w0 * bf_lo(xa[0][q][e]) + w1 * bf_lo(xa[1][q][e]) + w2 * bf_lo(xa[2][q][e]);
                    o[q * 8 + 2 * e + 1] = w0 * bf_hi(xa[0][q][e]) + w1 * bf_hi(xa[1][q][e]) + w2 * bf_hi(xa[2][q][e]);
                }
            }
#pragma unroll
            for (int e = 0; e < 16; ++e) ss += o[e] * o[e];
            float r = rsqrtf(wave_sum(ss) * (1.f / 1024.f) + EPS);
#pragma unroll
            for (int q = 0; q < 2; ++q) {
                const f32x4 ga = *(const f32x4*)(p.gn_a + q * 512 + lane * 8), gb = *(const f32x4*)(p.gn_a + q * 512 + lane * 8 + 4);
                u32x4 w;
                w.x = cvt_pk_bf16(o[q * 8 + 0] * r * ga[0], o[q * 8 + 1] * r * ga[1]); w.y = cvt_pk_bf16(o[q * 8 + 2] * r * ga[2], o[q * 8 + 3] * r * ga[3]);
                w.z = cvt_pk_bf16(o[q * 8 + 4] * r * gb[0], o[q * 8 + 5] * r * gb[1]); w.w = cvt_pk_bf16(o[q * 8 + 6] * r * gb[2], o[q * 8 + 7] * r * gb[3]);
                *(u32x4*)(mixed + (size_t)row * DM + q * 512 + lane * 8) = w;
            }
            ss = 0.f;
#pragma unroll
            for (int q = 0; q < 2; ++q) {
                const int h = q * 4 + (lane >> 4);
                const bf16_t* gp = proj + (size_t)row * NQ + 2048 + h * 3;
                const float g0 = 1.f / (1.f + __expf(-bf1(gp[0]))), g1 = 1.f / (1.f + __expf(-bf1(gp[1]))), g2 = 1.f / (1.f + __expf(-bf1(gp[2])));
#pragma unroll
                for (int e = 0; e < 4; ++e) {
                    o[q * 8 + 2 * e] = g0 * bf_lo(xb[0][q][e]) + g1 * bf_lo(xb[1][q][e]) + g2 * bf_lo(xb[2][q][e]);
                    o[q * 8 + 2 * e + 1] = g0 * bf_hi(xb[0][q][e]) + g1 * bf_hi(xb[1][q][e]) + g2 * bf_hi(xb[2][q][e]);
                }
            }
#pragma unroll
            for (int e = 0; e < 16; ++e) ss += o[e] * o[e];
            r = rsqrtf(wave_sum(ss) * (1.f / 1024.f) + EPS);
#pragma unroll
            for (int q = 0; q < 2; ++q) {
                const f32x4 ga = *(const f32x4*)(p.gn_b + q * 512 + lane * 8), gb = *(const f32x4*)(p.gn_b + q * 512 + lane * 8 + 4);
                u32x4 w;
                w.x = cvt_pk_bf16(o[q * 8 + 0] * r * ga[0], o[q * 8 + 1] * r * ga[1]); w.y = cvt_pk_bf16(o[q * 8 + 2] * r * ga[2], o[q * 8 + 3] * r * ga[3]);
                w.z = cvt_pk_bf16(o[q * 8 + 4] * r * gb[0], o[q * 8 + 5] * r * gb[1]); w.w = cvt_pk_bf16(o[q * 8 + 6] * r * gb[2], o[q * 8 + 7] * r * gb[3]);
                *(u32x4*)(mixed + (size_t)row * DM + 1024 + q * 512 + lane * 8) = w;
            }
        }
    }
    GRID_SYNC();

    {
        pg8::Gemm g{mixed, Wt_out, T_, DM, DM, DM, DM}; pg8::StaticOrder S; S.init(T_, DM, G, bx);
        EpiWout E{p.x, hb, rsq2};
        pg8::gemm_phase<EpiWout, pg8::StaticOrder>(lds, g, S, E);
    }
    GRID_SYNC();

    {
        pg8::Gemm g{hb, Wt_gu, T_, 2 * FF, DM, DM, DM}; pg8::StaticOrder S; S.init(T_, 2 * FF, G, bx);
        EpiSwiglu E{act, rsq2};
        pg8::gemm_phase<EpiSwiglu, pg8::StaticOrder>(lds, g, S, E);
    }
    GRID_SYNC();

    {
        pg8::Gemm g{act, Wt_dn, T_, DM, FF, FF, FF}; pg8::StaticOrder S; S.init(T_, DM, G, bx);
        EpiDown E{hb, mixed, rsq3};
        pg8::gemm_phase<EpiDown, pg8::StaticOrder>(lds, g, S, E);
    }
    GRID_SYNC();

    {
        const int gw = bx * 8 + wid, NGW = G * 8;
        for (int row0 = gw; row0 < T_; row0 += 4 * NGW) {
            u32x4 yv[4][4];
#pragma unroll
            for (int i = 0; i < 4; ++i) {
                const int row = row0 + i * NGW;
                if (row < T_) {
#pragma unroll
                    for (int q = 0; q < 4; ++q) yv[i][q] = __builtin_nontemporal_load((const u32x4*)(mixed + (size_t)row * DM + q * 512 + lane * 8));
                }
            }
#pragma unroll
            for (int i = 0; i < 4; ++i) {
                const int row = row0 + i * NGW;
                if (row < T_) {
                    const float r = rsqrtf(rsq3[row] * (1.f / DM) + EPS);
#pragma unroll
                    for (int q = 0; q < 4; ++q) {
                        const f32x4 ga = *(const f32x4*)(p.final_g + q * 512 + lane * 8), gb = *(const f32x4*)(p.final_g + q * 512 + lane * 8 + 4);
                        const u32x4 w = yv[i][q];
                        f32x4 o0, o1;
                        o0[0] = bf_lo(w.x) * r * ga[0]; o0[1] = bf_hi(w.x) * r * ga[1]; o0[2] = bf_lo(w.y) * r * ga[2]; o0[3] = bf_hi(w.y) * r * ga[3];
                        o1[0] = bf_lo(w.z) * r * gb[0]; o1[1] = bf_hi(w.z) * r * gb[1]; o1[2] = bf_lo(w.w) * r * gb[2]; o1[3] = bf_hi(w.w) * r * gb[3];
                        float* dst = p.out + (size_t)row * DM + q * 512 + lane * 8;
                        __builtin_nontemporal_store(o0, (f32x4*)dst); __builtin_nontemporal_store(o1, (f32x4*)(dst + 4));
                    }
                }
            }
        }
    }
}

extern "C" void kernel_launch(void* const* d_in, const int* in_sizes, int n_in, void* d_out, int out_size, void* d_ws, size_t ws_size, hipStream_t stream) {
    static int grid_blocks = 0;
    if (grid_blocks == 0) {
        if (n_in != 17 || out_size != T_ * DM || ws_size < WS_END) { fprintf(stderr, "kernel_launch: unexpected shapes / workspace (n_in %d out %d ws %zu need %zu)\n", n_in, out_size, ws_size, (size_t)WS_END); grid_blocks = -1; return; }
        int dev = 0, cus = 0, per_cu = 0;
        hipGetDevice(&dev);
        hipDeviceGetAttribute(&cus, hipDeviceAttributeMultiprocessorCount, dev);
        if (hipFuncSetAttribute((const void*)fwd_mega, hipFuncAttributeMaxDynamicSharedMemorySize, LDS_BYTES) != hipSuccess) { fprintf(stderr, "kernel_launch: hipFuncSetAttribute failed\n"); grid_blocks = -1; return; }
        if (hipOccupancyMaxActiveBlocksPerMultiprocessor(&per_cu, (const void*)fwd_mega, 512, LDS_BYTES) != hipSuccess || per_cu < 1) { fprintf(stderr, "kernel_launch: occupancy query failed (%d)\n", per_cu); per_cu = 1; (void)hipGetLastError(); }
        if (per_cu > 1) per_cu = 1;
        grid_blocks = cus * per_cu;
    }
    if (grid_blocks < 0) return;
    Params p{};
    p.x = (const float*)d_in[0]; p.norm1_g = (const float*)d_in[1]; p.w_in = (const float*)d_in[2];
    p.pe_k = (const float*)d_in[3]; p.w1_k = (const float*)d_in[4]; p.w2_k = (const float*)d_in[5];
    p.pe_v = (const float*)d_in[6]; p.w1_v = (const float*)d_in[7]; p.w2_v = (const float*)d_in[8];
    p.gn_a = (const float*)d_in[9]; p.gn_b = (const float*)d_in[10]; p.w_out = (const float*)d_in[11]; p.norm2_g = (const float*)d_in[12];
    p.w_gate = (const float*)d_in[13]; p.w_up = (const float*)d_in[14]; p.w_down = (const float*)d_in[15]; p.final_g = (const float*)d_in[16];
    p.out = (float*)d_out; p.ws = (unsigned char*)d_ws;
    void* args[] = {&p};
    hipError_t e = hipLaunchCooperativeKernel((const void*)fwd_mega, dim3(grid_blocks), dim3(512), args, LDS_BYTES, stream);
    if (e != hipSuccess) fprintf(stderr, "cooperative launch failed: %s (grid %d)\n", hipGetErrorString(e), grid_blocks);
}
```

```cpp
#include <hip/hip_runtime.h>
#include <hip/hip_cooperative_groups.h>
#include <cstdio>
#include <cstdint>
namespace cg = cooperative_groups;

#define LAS __attribute__((address_space(3)))
typedef unsigned short bf16_t;
typedef short bf16x8 __attribute__((ext_vector_type(8)));
typedef float f32x4 __attribute__((ext_vector_type(4)));
typedef unsigned u32x4 __attribute__((ext_vector_type(4)));
typedef unsigned u32x2 __attribute__((ext_vector_type(2)));

constexpr int T_ = 16384, S_ = 4096, DM = 2048, PIN = 5656, NP = 5888, FF = 5632;
constexpr float EPS = 1e-6f;
constexpr float LOG2E = 1.4426950408889634f, LN2 = 0.6931471805599453f;
constexpr float C2 = 0.08838834764831845f * 1.4426950408889634f;

constexpr size_t al256(size_t x) { return (x + 255) & ~(size_t)255; }
constexpr size_t WS_CTL = 0;
constexpr size_t WS_BAR = 2048;
constexpr size_t WS_RSQ2 = 4096;
constexpr size_t WS_RSQ3 = WS_RSQ2 + (size_t)T_ * 4;
constexpr size_t WS_BIASC = WS_RSQ3 + (size_t)T_ * 4;
constexpr size_t WS_BIASP = al256(WS_BIASC + 2048);
constexpr size_t WS_WIN = al256(WS_BIASP + 131072);
constexpr size_t WS_WOUT = WS_WIN + (size_t)NP * DM * 2;
constexpr size_t WS_WGU = WS_WOUT + (size_t)DM * DM * 2;
constexpr size_t WS_WDN = WS_WGU + (size_t)2 * FF * DM * 2;
constexpr size_t WS_WC1 = WS_WDN + (size_t)DM * FF * 2;
constexpr size_t WS_W2T = WS_WC1 + (size_t)2 * 256 * 4096 * 2;
constexpr size_t WS_HID = WS_W2T + (size_t)2 * 128 * 256 * 2;
constexpr size_t WS_KVC = WS_HID + (size_t)2 * 8 * 256 * 256 * 2;
constexpr size_t WS_LSE = WS_KVC + (size_t)2 * 8 * 256 * 128 * 2;
constexpr size_t WS_R1 = WS_LSE + (size_t)3 * T_ * 8 * 4;
constexpr int NQ = 2304;
constexpr size_t WS_PROJ = WS_R1 + (size_t)T_ * DM * 2;
constexpr size_t WS_KVA = WS_PROJ + (size_t)T_ * NQ * 2;
constexpr size_t WS_KVS = WS_KVA + (size_t)2 * 4 * 8 * 4096 * 128 * 2;
constexpr size_t WS_CRAW = WS_KVS + (size_t)4 * 4 * 2 * 4096 * 128 * 2;
constexpr size_t WS_OB = WS_CRAW + (size_t)2 * 8 * 4096 * 128 * 2 + 16384;
constexpr size_t WS_END = WS_OB + (size_t)3 * T_ * 1024 * 2;
static_assert(WS_OB - WS_PROJ >= (size_t)T_ * FF * 2, "act overlay");
static_assert(WS_END <= (size_t)536870912, "workspace");

constexpr int LDS_BYTES = 131072 + 1024;
constexpr int LDS_SLOT = 131072;

typedef __bf16 bf16v2 __attribute__((ext_vector_type(2)));
typedef float f32x2 __attribute__((ext_vector_type(2)));
__device__ __forceinline__ unsigned cvt_pk_bf16(float lo, float hi) { f32x2 v = {lo, hi}; bf16v2 b = __builtin_convertvector(v, bf16v2); return __builtin_bit_cast(unsigned, b); }
__device__ __forceinline__ float bf_lo(unsigned w) { return __uint_as_float(w << 16); }
__device__ __forceinline__ float bf_hi(unsigned w) { return __uint_as_float(w & 0xffff0000u); }
__device__ __forceinline__ float bf1(bf16_t b) { return __uint_as_float(((unsigned)b) << 16); }
__device__ __forceinline__ float wave_sum(float v) {
#pragma unroll
    for (int o = 1; o < 64; o <<= 1) v += __shfl_xor(v, o);
    return v;
}

namespace pg8 {
constexpr int BM = 256, BK = 64, HALF = 128, HTB = HALF * BK * 2, STAGE_BYTES = 8 * HTB, NXCD = 8, WGM = 4;
__host__ __device__ __forceinline__ int lds_byte(int r, int c) { const int st = (r >> 4) * 2 + (c >> 5), rr = r & 15, cc = c & 31, ob = rr * 64 + cc * 2; return st * 1024 + (ob ^ (((ob >> 9) & 1) << 5)); }
__host__ __device__ __forceinline__ void stage_rc(int b, int& R, int& C) { const int st = b / 1024, sb = b % 1024, swz = sb ^ (((sb >> 9) & 1) << 5); R = (st >> 1) * 16 + swz / 64; C = (st & 1) * 32 + (swz % 64) / 2; }
__host__ __device__ __forceinline__ int perm32(int rho) { const int n = rho >> 4, i = rho & 15; return 8 * (i >> 2) + 4 * n + (i & 3); }
struct Unit { int pm, pn; };
struct Gemm { const bf16_t* A; const bf16_t* Bt; int M, N, K, lda, ldb; };
struct StaticOrder {
    int nM, nN, nwg, G, c;
    __device__ void init(int M, int N, int G_, int c_) { nM = M / BM; nN = N / BM; nwg = nM * nN; G = G_; c = c_; }
    __device__ bool next(int i, Unit& u) const {
        const long L = (long)i * G + c; if (L >= nwg) return false;
        int wgid = (int)L; { const int q = nwg / NXCD, r = nwg % NXCD, xcd = wgid % NXCD, off = wgid / NXCD; wgid = (xcd < r ? xcd * (q + 1) : r * (q + 1) + (xcd - r) * q) + off; }
        const int nig = WGM * nN, gid = wgid / nig, fm = gid * WGM, gsz = (nM - fm) < WGM ? (nM - fm) : WGM;
        u.pm = fm + ((wgid % nig) % gsz); u.pn = (wgid % nig) / gsz; return true;
    }
};
struct SingleOrder {
    int pm;
    __device__ bool next(int i, Unit& u) const { if (i != 0) return false; u.pm = pm; u.pn = 0; return true; }
};

template <class Epi, class Sched>
__device__ __forceinline__ void gemm_phase(LAS unsigned char* lds, const Gemm g, const Sched& S, const Epi& E) {
    int tid_ = threadIdx.x; asm volatile("" : "+v"(tid_));
    const int tid = tid_, wid = __builtin_amdgcn_readfirstlane(tid >> 6), lane = tid & 63, wr = wid >> 2, wc = wid & 3, fr = lane & 15, fq = lane >> 4;
    const int K = g.K, nt = K / BK;
    unsigned voffA[2], voffB[2];
#pragma unroll
    for (int i = 0; i < 2; ++i) { int R, C; stage_rc(tid * 16 + i * 8192, R, C);
        const int Rb = (R & ~31) + perm32(R & 31);
        voffA[i] = (unsigned)(R * g.lda + C) * 2u; voffB[i] = (unsigned)(Rb * g.ldb + C) * 2u; }
    const size_t kstep = (size_t)(BK * 2);
    const size_t hstepA = (size_t)HALF * g.lda * 2, hstepB = (size_t)HALF * g.ldb * 2;
    const size_t tstepA = 2 * hstepA, tstepB = 2 * hstepB;
    const unsigned ldsw = (unsigned)wid * 1024u;
    const int aoff = lds_byte(wr * 64 + fr, fq * 8), boff = lds_byte(wc * 32 + fr, fq * 8);
#define PG8_SA(b, h) (((b) * 2 + (h)) * HTB)
#define PG8_SB(b, h) ((4 + (b) * 2 + (h)) * HTB)
#define PG8_STAGE(bufoff, gbase, voff) do { _Pragma("unroll") for (int _i = 0; _i < 2; ++_i) \
        __builtin_amdgcn_global_load_lds((const unsigned*)((const char*)(gbase) + (voff)[_i]), (LAS unsigned*)(lds + (bufoff) + ldsw + _i * 8192), 16, 0, 0); } while (0)
#define PG8_LDA(dst, b, h) do { _Pragma("unroll") for (int m = 0; m < 4; ++m) _Pragma("unroll") for (int k = 0; k < 2; ++k) dst[m][k] = *(const LAS bf16x8*)(lds + PG8_SA(b, h) + aoff + m * 2048 + k * 1024); } while (0)
#define PG8_LDB(dst, b, h) do { _Pragma("unroll") for (int n = 0; n < 2; ++n) _Pragma("unroll") for (int k = 0; k < 2; ++k) dst[n][k] = *(const LAS bf16x8*)(lds + PG8_SB(b, h) + boff + n * 2048 + k * 1024); } while (0)
#define PG8_MMA(ai, bj, At, Bt) do { __builtin_amdgcn_s_setprio(1); _Pragma("unroll") for (int m = 0; m < 4; ++m) _Pragma("unroll") for (int n = 0; n < 2; ++n) _Pragma("unroll") for (int k = 0; k < 2; ++k) \
        acc[ai][bj][m][n] = __builtin_amdgcn_mfma_f32_16x16x32_bf16(Bt[n][k], At[m][k], acc[ai][bj][m][n], 0, 0, 0); __builtin_amdgcn_s_setprio(0); } while (0)
#define PG8_WAIT_V(n) asm volatile("s_waitcnt vmcnt(" #n ")" ::: "memory")
#define PG8_WAIT_L(n) asm volatile("s_waitcnt lgkmcnt(" #n ")" ::: "memory")
#define PG8_BAR __builtin_amdgcn_s_barrier()
#define PG8_SCHED __builtin_amdgcn_sched_barrier(0)
    Unit cur, nxt; int ui = 0;
    if (!S.next(0, cur)) return;
    f32x4 acc[2][2][4][2];
#pragma unroll
    for (int a = 0; a < 2; ++a)
#pragma unroll
        for (int b = 0; b < 2; ++b)
#pragma unroll
            for (int m = 0; m < 4; ++m)
#pragma unroll
                for (int n = 0; n < 2; ++n) acc[a][b][m][n] = (f32x4){0.f, 0.f, 0.f, 0.f};
    bf16x8 At[4][2], B0[2][2], B1[2][2];
    const char* cA = (const char*)g.A + (size_t)cur.pm * tstepA; const char* cB = (const char*)g.Bt + (size_t)cur.pn * tstepB;
    PG8_STAGE(PG8_SB(0, 0), cB, voffB); PG8_STAGE(PG8_SB(0, 1), cB + hstepB, voffB); PG8_STAGE(PG8_SA(0, 0), cA, voffA); PG8_STAGE(PG8_SA(0, 1), cA + hstepA, voffA);
    if (wr == 1) PG8_BAR;
    PG8_WAIT_V(2); PG8_BAR;
    PG8_STAGE(PG8_SB(1, 0), cB + kstep, voffB); PG8_STAGE(PG8_SA(1, 0), cA + kstep, voffA); PG8_STAGE(PG8_SB(1, 1), cB + hstepB + kstep, voffB);
    PG8_WAIT_V(6); PG8_BAR;
    for (;;) {
        const bool has_next = S.next(ui + 1, nxt);
        const char* nA = has_next ? (const char*)g.A + (size_t)nxt.pm * tstepA : cA; const char* nB = has_next ? (const char*)g.Bt + (size_t)nxt.pn * tstepB : cB;
        for (int t = 0; t < nt; t += 2) {
            const bool last = (t == nt - 2);
            const char* a1 = cA + (size_t)(t + 1) * kstep;
            const char* a2 = last ? nA : cA + (size_t)(t + 2) * kstep; const char* b2 = last ? nB : cB + (size_t)(t + 2) * kstep;
            const char* a3 = a2 + kstep; const char* b3 = b2 + kstep;
            PG8_LDB(B0, 0, 0); PG8_LDB(B1, 0, 1); PG8_SCHED; PG8_LDA(At, 0, 0); PG8_STAGE(PG8_SA(1, 1), a1 + hstepA, voffA);
            PG8_WAIT_V(8); PG8_WAIT_L(0); PG8_BAR; PG8_MMA(0, 0, At, B0); PG8_MMA(0, 1, At, B1); PG8_BAR; PG8_SCHED;
            PG8_LDA(At, 0, 1); PG8_STAGE(PG8_SB(0, 0), b2, voffB); PG8_STAGE(PG8_SB(0, 1), b2 + hstepB, voffB); PG8_STAGE(PG8_SA(0, 0), a2, voffA);
            PG8_WAIT_V(8); PG8_WAIT_L(0); PG8_BAR; PG8_MMA(1, 0, At, B0); PG8_MMA(1, 1, At, B1); PG8_BAR; PG8_SCHED;
            PG8_LDB(B0, 1, 0); PG8_LDB(B1, 1, 1); PG8_SCHED; PG8_LDA(At, 1, 0); PG8_STAGE(PG8_SA(0, 1), a2 + hstepA, voffA);
            PG8_WAIT_V(8); PG8_WAIT_L(0); PG8_BAR; PG8_MMA(0, 0, At, B0); PG8_MMA(0, 1, At, B1); PG8_BAR; PG8_SCHED;
            PG8_LDA(At, 1, 1); PG8_STAGE(PG8_SB(1, 0), b3, voffB); PG8_STAGE(PG8_SB(1, 1), b3 + hstepB, voffB); PG8_STAGE(PG8_SA(1, 0), a3, voffA);
            PG8_WAIT_V(8); PG8_WAIT_L(0); PG8_BAR; PG8_MMA(1, 0, At, B0); PG8_MMA(1, 1, At, B1); PG8_BAR; PG8_SCHED;
        }
        if (wr == 0) PG8_BAR;
        E(acc, cur, wr, wc, fr, fq);
        if (!has_next) break;
#pragma unroll
        for (int a = 0; a < 2; ++a)
#pragma unroll
            for (int b = 0; b < 2; ++b)
#pragma unroll
                for (int m = 0; m < 4; ++m)
#pragma unroll
                    for (int n = 0; n < 2; ++n) acc[a][b][m][n] = (f32x4){0.f, 0.f, 0.f, 0.f};
        cur = nxt; cA = nA; cB = nB; ++ui;
        if (wr == 1) PG8_BAR;
    }
    PG8_WAIT_V(0);
    PG8_BAR;
#undef PG8_SA
#undef PG8_SB
#undef PG8_STAGE
#undef PG8_LDA
#undef PG8_LDB
#undef PG8_MMA
#undef PG8_WAIT_V
#undef PG8_WAIT_L
#undef PG8_BAR
#undef PG8_SCHED
}
}

typedef f32x4 Acc[2][2][4][2];

struct EpiProj {
    bf16_t* projq; bf16_t* kva; bf16_t* kvs; bf16_t* craw;
    __device__ __forceinline__ void operator()(const Acc& acc, const pg8::Unit& u, int wr, int wc, int fr, int fq) const {
        const int pn = u.pn;
        bf16_t* base; long SJ, SB, ST;
        if (pn < 4)       { base = projq + pn * 256;                                   SJ = 128; SB = (long)4096 * NQ; ST = NQ; }
        else if (pn < 8)  { base = kva + (size_t)((pn - 4) * 2) * 4096 * 128;          SJ = (long)4096 * 128; SB = (long)8 * 4096 * 128; ST = 128; }
        else if (pn < 12) { base = kva + (size_t)4 * 8 * 4096 * 128 + (size_t)((pn - 8) * 2) * 4096 * 128; SJ = (long)4096 * 128; SB = (long)8 * 4096 * 128; ST = 128; }
        else if (pn < 16) { base = projq + 1024 + (pn - 12) * 256;                     SJ = 128; SB = (long)4096 * NQ; ST = NQ; }
        else if (pn < 18) { base = craw + (size_t)(pn - 16) * (8 * 4096 * 128);        SJ = (long)4096 * 128; SB = (long)2 * 4096 * 128; ST = 128; }
        else if (pn < 22) { base = kvs + (size_t)(pn - 18) * (4 * 2 * 4096 * 128);     SJ = (long)4096 * 128; SB = (long)2 * 4096 * 128; ST = 128; }
        else              { base = projq + 2048;                                       SJ = 128; SB = (long)4096 * NQ; ST = NQ; }
        const int row0 = u.pm * 256 + wr * 64 + fr;
        bf16_t* lanep = base + (long)(row0 >> 12) * SB + (long)(row0 & 4095) * ST + wc * 32 + fq * 8;
#pragma unroll
        for (int ai = 0; ai < 2; ++ai)
#pragma unroll
            for (int m = 0; m < 4; ++m) {
                bf16_t* rowp = lanep + (long)(ai * 128 + m * 16) * ST;
#pragma unroll
                for (int bj = 0; bj < 2; ++bj) {
                    const f32x4 v0 = acc[ai][bj][m][0], v1 = acc[ai][bj][m][1];
                    u32x4 w; w.x = cvt_pk_bf16(v0[0], v0[1]); w.y = cvt_pk_bf16(v0[2], v0[3]); w.z = cvt_pk_bf16(v1[0], v1[1]); w.w = cvt_pk_bf16(v1[2], v1[3]);
                    *(u32x4*)(rowp + bj * SJ) = w;
                }
            }
    }
};
struct EpiHid {
    bf16_t* hid; const float* bias;
    __device__ __forceinline__ void operator()(const Acc& acc, const pg8::Unit& u, int wr, int wc, int fr, int fq) const {
#pragma unroll
        for (int bj = 0; bj < 2; ++bj)
#pragma unroll
            for (int n = 0; n < 2; ++n) {
                const int col = bj * 128 + wc * 32 + fq * 8 + n * 4;
                const f32x4 bv = *(const f32x4*)(bias + col);
#pragma unroll
                for (int ai = 0; ai < 2; ++ai)
#pragma unroll
                    for (int m = 0; m < 4; ++m) {
                        const int row = ai * 128 + wr * 64 + m * 16 + fr;
                        f32x4 v = acc[ai][bj][m][n] + bv;
#pragma unroll
                        for (int j = 0; j < 4; ++j) v[j] = v[j] * __builtin_amdgcn_rcpf(1.f + __expf(-v[j]));
                        u32x2 w; w.x = cvt_pk_bf16(v[0], v[1]); w.y = cvt_pk_bf16(v[2], v[3]);
                        *(u32x2*)(hid + (size_t)row * 256 + col) = w;
                    }
            }
    }
};
struct EpiWout {
    const float* x; bf16_t* hb; float* rsq;
    __device__ __forceinline__ void operator()(const Acc& acc, const pg8::Unit& u, int wr, int wc, int fr, int fq) const {
#pragma unroll
        for (int ai = 0; ai < 2; ++ai)
#pragma unroll
            for (int m = 0; m < 4; ++m) {
                const int row = u.pm * 256 + ai * 128 + wr * 64 + m * 16 + fr;
                float ss = 0.f;
#pragma unroll
                for (int bj = 0; bj < 2; ++bj) {
                    const size_t off = (size_t)row * DM + u.pn * 256 + bj * 128 + wc * 32 + fq * 8;
                    const f32x4 h0 = *(const f32x4*)(x + off) + acc[ai][bj][m][0], h1 = *(const f32x4*)(x + off + 4) + acc[ai][bj][m][1];
                    u32x4 w; w.x = cvt_pk_bf16(h0[0], h0[1]); w.y = cvt_pk_bf16(h0[2], h0[3]); w.z = cvt_pk_bf16(h1[0], h1[1]); w.w = cvt_pk_bf16(h1[2], h1[3]);
                    *(u32x4*)(hb + off) = w;
                    ss += (h0[0] * h0[0] + h0[1] * h0[1]) + (h0[2] * h0[2] + h0[3] * h0[3]) + (h1[0] * h1[0] + h1[1] * h1[1]) + (h1[2] * h1[2] + h1[3] * h1[3]);
                }
                ss += __shfl_xor(ss, 16); ss += __shfl_xor(ss, 32);
                if (fq == 0) atomicAdd(rsq + row, ss);
            }
    }
};
struct EpiSwiglu {
    bf16_t* act; const float* rsq;
    __device__ __forceinline__ void operator()(const Acc& acc, const pg8::Unit& u, int wr, int wc, int fr, int fq) const {
#pragma unroll
        for (int ai = 0; ai < 2; ++ai)
#pragma unroll
            for (int m = 0; m < 4; ++m) {
                const int row = u.pm * 256 + ai * 128 + wr * 64 + m * 16 + fr;
                const float r = rsqrtf(rsq[row] * (1.f / DM) + EPS);
                u32x4 w;
#pragma unroll
                for (int n = 0; n < 2; ++n) {
                    const f32x4 g = acc[ai][0][m][n] * r, up = acc[ai][1][m][n] * r;
                    f32x4 a;
#pragma unroll
                    for (int j = 0; j < 4; ++j) a[j] = g[j] * __builtin_amdgcn_rcpf(1.f + __expf(-g[j])) * up[j];
                    w[2 * n] = cvt_pk_bf16(a[0], a[1]); w[2 * n + 1] = cvt_pk_bf16(a[2], a[3]);
                }
                *(u32x4*)(act + (size_t)row * FF + u.pn * 128 + wc * 32 + fq * 8) = w;
            }
    }
};
struct EpiDown {
    const bf16_t* hb; bf16_t* out; float* rsq;
    __device__ __forceinline__ void operator()(const Acc& acc, const pg8::Unit& u, int wr, int wc, int fr, int fq) const {
#pragma unroll
        for (int ai = 0; ai < 2; ++ai)
#pragma unroll
            for (int m = 0; m < 4; ++m) {
                const int row = u.pm * 256 + ai * 128 + wr * 64 + m * 16 + fr;
                float ss = 0.f;
#pragma unroll
                for (int bj = 0; bj < 2; ++bj) {
                    const size_t off = (size_t)row * DM + u.pn * 256 + bj * 128 + wc * 32 + fq * 8;
                    const u32x4 hw = *(const u32x4*)(hb + off);
                    f32x4 y0 = acc[ai][bj][m][0], y1 = acc[ai][bj][m][1];
                    y0[0] += bf_lo(hw.x); y0[1] += bf_hi(hw.x); y0[2] += bf_lo(hw.y); y0[3] += bf_hi(hw.y);
                    y1[0] += bf_lo(hw.z); y1[1] += bf_hi(hw.z); y1[2] += bf_lo(hw.w); y1[3] += bf_hi(hw.w);
                    { u32x4 w; w.x = cvt_pk_bf16(y0[0], y0[1]); w.y = cvt_pk_bf16(y0[2], y0[3]); w.z = cvt_pk_bf16(y1[0], y1[1]); w.w = cvt_pk_bf16(y1[2], y1[3]); *(u32x4*)(out + off) = w; }
                    ss += (y0[0] * y0[0] + y0[1] * y0[1]) + (y0[2] * y0[2] + y0[3] * y0[3]) + (y1[0] * y1[0] + y1[1] * y1[1]) + (y1[2] * y1[2] + y1[3] * y1[3]);
                }
                ss += __shfl_xor(ss, 16); ss += __shfl_xor(ss, 32);
                if (fq == 0) atomicAdd(rsq + row, ss);
            }
    }
};

constexpr int KP = 136, VPN = 144;
constexpr int LDS_K = 0, LDS_V = 64 * KP * 2;
constexpr int LDS_SCO = 36864;
constexpr int LDS_WU = LDS_SCO + 8 * 2048;

struct Stage { u32x4 k0, k1, v0, v1; };
__device__ __forceinline__ void stage_load(Stage& st, const bf16_t* kb, const bf16_t* vb, long pitch, int tid) {
    const int p0 = tid, p1 = tid + 512;
    st.k0 = *(const u32x4*)(kb + (long)(p0 >> 4) * pitch + (p0 & 15) * 8);
    st.k1 = *(const u32x4*)(kb + (long)(p1 >> 4) * pitch + (p1 & 15) * 8);
    st.v0 = *(const u32x4*)(vb + (long)(p0 >> 4) * pitch + (p0 & 15) * 8);
    st.v1 = *(const u32x4*)(vb + (long)(p1 >> 4) * pitch + (p1 & 15) * 8);
}
__device__ __forceinline__ void stage_load_k(Stage& st, const bf16_t* kb, long pitch, int tid) {
    const int p0 = tid, p1 = tid + 512;
    st.k0 = *(const u32x4*)(kb + (long)(p0 >> 4) * pitch + (p0 & 15) * 8);
    st.k1 = *(const u32x4*)(kb + (long)(p1 >> 4) * pitch + (p1 & 15) * 8);
}
__device__ __forceinline__ void stage_store_k(const Stage& st, LAS unsigned char* lds, int tid) {
    const int p0 = tid, p1 = tid + 512;
    *(LAS u32x4*)(lds + LDS_K + (p0 >> 4) * (KP * 2) + (p0 & 15) * 16) = st.k0;
    *(LAS u32x4*)(lds + LDS_K + (p1 >> 4) * (KP * 2) + (p1 & 15) * 16) = st.k1;
}
__device__ __forceinline__ void stage_store(const Stage& st, LAS unsigned char* lds, int tid) {
    const int p0 = tid, p1 = tid + 512;
    *(LAS u32x4*)(lds + LDS_K + (p0 >> 4) * (KP * 2) + (p0 & 15) * 16) = st.k0;
    *(LAS u32x4*)(lds + LDS_K + (p1 >> 4) * (KP * 2) + (p1 & 15) * 16) = st.k1;
    *(LAS u32x4*)(lds + LDS_V + (p0 >> 4) * (VPN * 2) + (p0 & 15) * 16) = st.v0;
    *(LAS u32x4*)(lds + LDS_V + (p1 >> 4) * (VPN * 2) + (p1 & 15) * 16) = st.v1;
}
template <int NRG>
__device__ __forceinline__ void qk_tile(LAS unsigned char* lds, const bf16x8 (&qf)[NRG][4], f32x4 (&sc)[NRG][4], int fr, int fq) {
#pragma unroll
    for (int s = 0; s < 4; ++s) {
#pragma unroll
        for (int rg = 0; rg < NRG; ++rg) sc[rg][s] = (f32x4){0.f, 0.f, 0.f, 0.f};
#pragma unroll
        for (int kk = 0; kk < 4; ++kk) {
            const bf16x8 kf = *(const LAS bf16x8*)(lds + LDS_K + (s * 16 + fr) * (KP * 2) + kk * 64 + fq * 16);
#pragma unroll
            for (int rg = 0; rg < NRG; ++rg) sc[rg][s] = __builtin_amdgcn_mfma_f32_16x16x32_bf16(kf, qf[rg][kk], sc[rg][s], 0, 0, 0);
        }
    }
}
typedef short s16x4 __attribute__((ext_vector_type(4)));
template <int NRG>
__device__ __forceinline__ void pv_tile(LAS unsigned char* lds, const bf16x8 (&pb)[NRG][2], f32x4 (&o)[NRG][8], int fr, int fq) {
    LAS unsigned char* vbase = lds + LDS_V + (4 * fq + (fr >> 2)) * (VPN * 2) + (fr & 3) * 8;
#pragma unroll
    for (int c = 0; c < 8; ++c)
#pragma unroll
        for (int u = 0; u < 2; ++u) {
            const s16x4 lo = __builtin_amdgcn_ds_read_tr16_b64_v4i16((LAS s16x4*)(vbase + (32 * u) * (VPN * 2) + c * 32));
            const s16x4 hi = __builtin_amdgcn_ds_read_tr16_b64_v4i16((LAS s16x4*)(vbase + (32 * u + 16) * (VPN * 2) + c * 32));
            const bf16x8 vf = {lo[0], lo[1], lo[2], lo[3], hi[0], hi[1], hi[2], hi[3]};
#pragma unroll
            for (int rg = 0; rg < NRG; ++rg) o[rg][c] = __builtin_amdgcn_mfma_f32_16x16x32_bf16(vf, pb[rg][u], o[rg][c], 0, 0, 0);
        }
}
__device__ __forceinline__ bf16x8 pack8(const f32x4 a, const f32x4 b) {
    u32x4 w = {cvt_pk_bf16(a[0], a[1]), cvt_pk_bf16(a[2], a[3]), cvt_pk_bf16(b[0], b[1]), cvt_pk_bf16(b[2], b[3])};
    return *reinterpret_cast<bf16x8*>(&w);
}
__device__ __forceinline__ void softmax_update(f32x4 (&x)[4], float& m, float& l, f32x4 (&o)[8], bf16x8 (&pb)[2]) {
    float mx = x[0][0];
#pragma unroll
    for (int s = 0; s < 4; ++s)
#pragma unroll
        for (int r = 0; r < 4; ++r) mx = fmaxf(mx, x[s][r]);
    mx = fmaxf(mx, __shfl_xor(mx, 16)); mx = fmaxf(mx, __shfl_xor(mx, 32));
    const float mn = fmaxf(m, mx);
    const float alpha = __builtin_amdgcn_exp2f(m - mn);
    m = mn;
    float ls = 0.f;
#pragma unroll
    for (int s = 0; s < 4; ++s)
#pragma unroll
        for (int r = 0; r < 4; ++r) { x[s][r] = __builtin_amdgcn_exp2f(x[s][r] - mn); ls += x[s][r]; }
    l = l * alpha + ls;
#pragma unroll
    for (int c = 0; c < 8; ++c) o[c] *= alpha;
    pb[0] = pack8(x[0], x[1]); pb[1] = pack8(x[2], x[3]);
}
template <bool MASK>
__device__ __forceinline__ void softmax_tile(f32x4 (&x)[4], float slope2, float base, int relb, unsigned W, float& m, float& l, f32x4 (&o)[8], bf16x8 (&pb)[2]) {
    float mx = -__builtin_inff();
#pragma unroll
    for (int s = 0; s < 4; ++s)
#pragma unroll
        for (int r = 0; r < 4; ++r) {
            const int k = 16 * s + r;
            float y = fmaf(x[s][r], C2, fmaf(slope2, (float)k, base));
            if (MASK) y = ((unsigned)(relb - k) <= W) ? y : -__builtin_inff();
            x[s][r] = y; mx = fmaxf(mx, y);
        }
    mx = fmaxf(mx, __shfl_xor(mx, 16)); mx = fmaxf(mx, __shfl_xor(mx, 32));
    float mn = m;
    if (!__all(mx - m <= 8.f)) {
        mn = fmaxf(m, mx);
        const float alpha = __builtin_amdgcn_exp2f(m - mn);
        m = mn; l *= alpha;
#pragma unroll
        for (int c = 0; c < 8; ++c) o[c] *= alpha;
    }
    float ls = 0.f;
#pragma unroll
    for (int s = 0; s < 4; ++s)
#pragma unroll
        for (int r = 0; r < 4; ++r) { x[s][r] = __builtin_amdgcn_exp2f(x[s][r] - mn); ls += x[s][r]; }
    l += ls;
    pb[0] = pack8(x[0], x[1]); pb[1] = pack8(x[2], x[3]);
}
__device__ __forceinline__ void store_o_row(bf16_t* dst, const f32x4 (&o)[8], float inv, int fq) {
#pragma unroll
    for (int c = 0; c < 8; ++c) {
        u32x2 w; w.x = cvt_pk_bf16(o[c][0] * inv, o[c][1] * inv); w.y = cvt_pk_bf16(o[c][2] * inv, o[c][3] * inv);
        *(u32x2*)(dst + c * 16 + fq * 4) = w;
    }
}

__device__ __forceinline__ void band_job(LAS unsigned char* lds, const bf16_t* qb, long qpitch, const bf16_t* kb, const bf16_t* vb, long kvpitch,
                                         int q0, int W, float slope2, bf16_t* ob, long opitch, float* lseb, long lsepitch) {
    int tid_ = threadIdx.x; asm volatile("" : "+v"(tid_));
    const int tid = tid_, wid = __builtin_amdgcn_readfirstlane(tid >> 6), lane = tid & 63, fr = lane & 15, fq = lane >> 4;
    bf16x8 qf[2][4]; f32x4 o[2][8]; float m[2], l[2]; int qi[2];
#pragma unroll
    for (int rg = 0; rg < 2; ++rg) {
        qi[rg] = q0 + wid * 32 + rg * 16 + fr;
#pragma unroll
        for (int kk = 0; kk < 4; ++kk) qf[rg][kk] = *(const bf16x8*)(qb + (long)qi[rg] * qpitch + kk * 32 + fq * 8);
#pragma unroll
        for (int c = 0; c < 8; ++c) o[rg][c] = (f32x4){0.f, 0.f, 0.f, 0.f};
        m[rg] = -1e30f; l[rg] = 0.f;
    }
    const int qa = q0 + wid * 32;
    const int kt_lo = (q0 - W > 0 ? q0 - W : 0) >> 6, kt_hi = (q0 + 255) >> 6;
    Stage st; stage_load(st, kb + (long)(kt_lo * 64) * kvpitch, vb + (long)(kt_lo * 64) * kvpitch, kvpitch, tid);
    for (int kt = kt_lo; kt <= kt_hi; ++kt) {
        __syncthreads();
        stage_store(st, lds, tid);
        __syncthreads();
        if (kt < kt_hi) stage_load(st, kb + (long)((kt + 1) * 64) * kvpitch, vb + (long)((kt + 1) * 64) * kvpitch, kvpitch, tid);
        const bool need = (kt * 64 <= qa + 31) && (kt * 64 + 63 >= qa - W);
        if (need) {
            bf16x8 pb[2][2]; f32x4 sc[2][4];
            qk_tile<2>(lds, qf, sc, fr, fq);
#pragma unroll
            for (int rg = 0; rg < 2; ++rg) {
                const int relb = qi[rg] - kt * 64 - fq * 4;
                const float base = -slope2 * (float)relb;
                softmax_tile<true>(sc[rg], slope2, base, relb, (unsigned)W, m[rg], l[rg], o[rg], pb[rg]);
            }
            pv_tile<2>(lds, pb, o, fr, fq);
        }
    }
#pragma unroll
    for (int rg = 0; rg < 2; ++rg) {
        float lt = l[rg]; lt += __shfl_xor(lt, 16); lt += __shfl_xor(lt, 32);
        const float inv = lt > 0.f ? 1.f / lt : 0.f;
        store_o_row(ob + (long)qi[rg] * opitch, o[rg], inv, fq);
        if (lseb && fq == 0) lseb[(long)qi[rg] * lsepitch] = (m[rg] + __log2f(lt)) * LN2;
    }
}

__device__ __forceinline__ void nsa_job(LAS unsigned char* lds, const bf16_t* proj, const bf16_t* ksv, const bf16_t* kc, const bf16_t* vc, bf16_t* ocmp, bf16_t* osel, int b, int g, int chunk, int half, bool dry = false) {
    int tid_ = threadIdx.x; asm volatile("" : "+v"(tid_));
    const int tid = tid_, wid = __builtin_amdgcn_readfirstlane(tid >> 6), lane = tid & 63, fr = lane & 15, fq = lane >> 4;
    const int t0 = chunk * 64, tq = t0 + half * 32 + wid * 4 + (fr & 3);
    const int head = fr >> 2, hq = g * 4 + head;
    const size_t rowbase = (size_t)(b * S_ + tq);
    const float slope2 = __builtin_amdgcn_exp2f(-(float)(hq + 1)) * LOG2E;
    bf16x8 qf[1][4]; f32x4 o[1][8]; float m = -1e30f, l = 0.f;
#pragma unroll
    for (int kk = 0; kk < 4; ++kk) qf[0][kk] = *(const bf16x8*)(proj + rowbase * NQ + 1024 + hq * 128 + kk * 32 + fq * 8);
    const bf16_t* kcb = kc + (size_t)(b * 2 + g) * 256 * 128; const bf16_t* vcb = vc + (size_t)(b * 2 + g) * 256 * 128;
    const int cmax = (t0 + 32) >> 4;
    const int ktc = (cmax >> 6) > 3 ? 3 : (cmax >> 6);
    Stage stA, stB;
    float imp[16];
#pragma unroll
    for (int i = 0; i < 16; ++i) imp[i] = 0.f;
#pragma unroll
    for (int c = 0; c < 8; ++c) o[0][c] = (f32x4){0.f, 0.f, 0.f, 0.f};
    {
        stage_load(stA, kcb, vcb, 128, tid);
        if (ktc >= 1) stage_load(stB, kcb + (size_t)64 * 128, vcb + (size_t)64 * 128, 128, tid);
#pragma unroll
        for (int kt = 0; kt < 4; ++kt) {
            if (kt <= ktc) {
                __syncthreads(); stage_store((kt & 1) ? stB : stA, lds, tid); __syncthreads();
                if (kt + 2 <= ktc) stage_load((kt & 1) ? stB : stA, kcb + (size_t)(kt + 2) * 64 * 128, vcb + (size_t)(kt + 2) * 64 * 128, 128, tid);
                f32x4 sc[1][4]; bf16x8 pb[1][2];
                qk_tile<1>(lds, qf, sc, fr, fq);
                const int relb = tq - 31 - 16 * (kt * 64 + fq * 4);
                float mx = -__builtin_inff();
#pragma unroll
                for (int s = 0; s < 4; ++s)
#pragma unroll
                    for (int r = 0; r < 4; ++r) {
                        const int rel = relb - 256 * s - 16 * r;
                        const float v = sc[0][s][r] * C2 - slope2 * (float)rel;
                        sc[0][s][r] = (rel >= 0) ? v : -__builtin_inff();
                        mx = fmaxf(mx, sc[0][s][r]);
                    }
                mx = fmaxf(mx, __shfl_xor(mx, 16)); mx = fmaxf(mx, __shfl_xor(mx, 32));
                const float mn = fmaxf(m, mx);
                const float alpha = __builtin_amdgcn_exp2f(m - mn);
                m = mn; l *= alpha;
#pragma unroll
                for (int c = 0; c < 8; ++c) o[0][c] *= alpha;
#pragma unroll
                for (int i = 0; i < 16; ++i) imp[i] *= alpha;
                float ls = 0.f;
#pragma unroll
                for (int s = 0; s < 4; ++s) {
#pragma unroll
                    for (int r = 0; r < 4; ++r) { sc[0][s][r] = __builtin_amdgcn_exp2f(sc[0][s][r] - mn); ls += sc[0][s][r]; }
                    const float own = (sc[0][s][0] + sc[0][s][1]) + (sc[0][s][2] + sc[0][s][3]);
                    const float recv = __shfl(sc[0][s][3], (lane - 16) & 63);
                    imp[kt * 4 + s] += own + (fq != 0 ? recv : 0.f);
                    if (kt * 4 + s + 1 < 16) imp[kt * 4 + s + 1] += (fq != 0 ? 0.f : recv);
                }
                l += ls;
                pb[0][0] = pack8(sc[0][0], sc[0][1]); pb[0][1] = pack8(sc[0][2], sc[0][3]);
                pv_tile<1>(lds, pb, o, fr, fq);
            }
        }
    }
    {
        float lt = l; lt += __shfl_xor(lt, 16); lt += __shfl_xor(lt, 32);
        const float inv = lt > 0.f ? 1.f / lt : 0.f;
#pragma unroll
        for (int i = 0; i < 16; ++i) imp[i] *= inv;
        if (!dry) store_o_row(ocmp + rowbase * 1024 + hq * 128, o[0], inv, fq);
    }
    float sco[16];
    LAS float* scw = (LAS float*)(lds + LDS_SCO + wid * 1024) + (fr & 3) * 64;
#pragma unroll
    for (int i = 0; i < 16; ++i) {
        float tot = imp[i] + __shfl_xor(imp[i], 4);
        tot = tot + __shfl_xor(tot, 8);
        const int n = 4 * i + fq;
        const bool valid = n <= chunk;
        const bool forced = (n == 0) || (valid && n > chunk - 2);
        sco[i] = valid ? tot + (forced ? 1000.f : 0.f) : -1.f;
        scw[n] = sco[i];
    }
    asm volatile("s_waitcnt lgkmcnt(0)" ::: "memory");
    int rank[16];
#pragma unroll
    for (int i = 0; i < 16; ++i) rank[i] = 0;
    for (int j = 0; j < 16; ++j) {
        const int n2 = head * 16 + j;
        const float v2 = scw[n2];
#pragma unroll
        for (int i = 0; i < 16; ++i) {
            const int n = 4 * i + fq;
            rank[i] += ((v2 > sco[i]) || (v2 == sco[i] && n2 < n)) ? 1 : 0;
        }
    }
    unsigned mlo = 0u, mhi = 0u;
#pragma unroll
    for (int i = 0; i < 16; ++i) {
        int rk = rank[i] + __shfl_xor(rank[i], 4);
        rk = rk + __shfl_xor(rk, 8);
        const int n = 4 * i + fq;
        const bool sel = (n <= chunk) && rk < 16;
        if (i < 8) mlo |= sel ? (1u << (n & 31)) : 0u; else mhi |= sel ? (1u << (n & 31)) : 0u;
    }
    mlo |= __shfl_xor(mlo, 16); mlo |= __shfl_xor(mlo, 32); mhi |= __shfl_xor(mhi, 16); mhi |= __shfl_xor(mhi, 32);
    unsigned wlo = mlo, whi = mhi;
#pragma unroll
    for (int x = 1; x < 4; x <<= 1) { wlo |= __shfl_xor(wlo, x); whi |= __shfl_xor(whi, x); }
    wlo = __builtin_amdgcn_readfirstlane(wlo); whi = __builtin_amdgcn_readfirstlane(whi);
    LAS unsigned* wu = (LAS unsigned*)(lds + LDS_WU);
    if (lane == 0) { wu[wid * 2] = wlo; wu[wid * 2 + 1] = whi; }
    __syncthreads();
    unsigned ulo = 0u, uhi = 0u;
#pragma unroll
    for (int w = 0; w < 8; ++w) { ulo |= wu[w * 2]; uhi |= wu[w * 2 + 1]; }
    ulo = __builtin_amdgcn_readfirstlane(ulo); uhi = __builtin_amdgcn_readfirstlane(uhi);
    const unsigned long long mymask = ((unsigned long long)mhi << 32) | mlo;
    const unsigned long long wmask = ((unsigned long long)whi << 32) | wlo;
    unsigned long long rem = ((unsigned long long)uhi << 32) | ulo;
    m = -1e30f; l = 0.f;
#pragma unroll
    for (int c = 0; c < 8; ++c) o[0][c] = (f32x4){0.f, 0.f, 0.f, 0.f};
    const bf16_t* ksb = ksv + (size_t)(b * 2 + g) * 4096 * 128; const bf16_t* vsb = ksv + (size_t)4 * 2 * 4096 * 128 + (size_t)(b * 2 + g) * 4096 * 128;
#define NSA_POP(var) do { if (rem != 0ull) { var = __builtin_ctzll(rem); rem &= rem - 1; } else var = -1; } while (0)
#define NSA_SEL_COMPUTE(n) do { if (!dry && ((wmask >> (n)) & 1ull)) { \
        f32x4 sc[1][4]; bf16x8 pb[1][2]; \
        qk_tile<1>(lds, qf, sc, fr, fq); \
        const bool mysel = (mymask >> (n)) & 1ull; \
        const int relb = tq - (n) * 64 - fq * 4; \
        const float base = mysel ? -slope2 * (float)relb : -__builtin_inff(); \
        if ((n) < chunk) softmax_tile<false>(sc[0], slope2, base, relb, 0x7fffffffu, m, l, o[0], pb[0]); \
        else softmax_tile<true>(sc[0], slope2, base, relb, 0x7fffffffu, m, l, o[0], pb[0]); \
        pv_tile<1>(lds, pb, o, fr, fq); } } while (0)
    {
        int na, nb, nc, nd;
        NSA_POP(na); NSA_POP(nb);
        stage_load(stA, ksb + (size_t)(na * 64) * 128, vsb + (size_t)(na * 64) * 128, 128, tid);
        if (nb >= 0) stage_load(stB, ksb + (size_t)(nb * 64) * 128, vsb + (size_t)(nb * 64) * 128, 128, tid);
        for (;;) {
            __syncthreads(); stage_store(stA, lds, tid); __syncthreads();
            NSA_POP(nc);
            if (nc >= 0) stage_load(stA, ksb + (size_t)(nc * 64) * 128, vsb + (size_t)(nc * 64) * 128, 128, tid);
            NSA_SEL_COMPUTE(na);
            if (nb < 0) break;
            __syncthreads(); stage_store(stB, lds, tid); __syncthreads();
            NSA_POP(nd);
            if (nd >= 0) stage_load(stB, ksb + (size_t)(nd * 64) * 128, vsb + (size_t)(nd * 64) * 128, 128, tid);
            NSA_SEL_COMPUTE(nb);
            if (nc < 0) break;
            na = nc; nb = nd;
        }
    }
#undef NSA_POP
#undef NSA_SEL_COMPUTE
    {
        float lt = l; lt += __shfl_xor(lt, 16); lt += __shfl_xor(lt, 32);
        const float iv = lt > 0.f ? 1.f / lt : 0.f;
        if (!dry) store_o_row(osel + rowbase * 1024 + hq * 128, o[0], iv, fq);
    }
}

__device__ __forceinline__ void transpose_item(const float* W, int K, int N, bf16_t* WT, int item, int nblk, LAS float* scr, int lane, const float* gk, int mode, int off) {
    const int kb = item / nblk, nb = item % nblk, k0 = 64 * kb, n0 = 32 * nb;
    const int nn = n0 + (lane & 31);
    const bool nok = nn < N;
    float v[32];
#pragma unroll
    for (int i = 0; i < 32; ++i) v[i] = nok ? __builtin_nontemporal_load(W + (size_t)(k0 + 2 * i + (lane >> 5)) * N + nn) : 0.f;
    if (gk) {
#pragma unroll
        for (int i = 0; i < 32; ++i) v[i] *= gk[k0 + 2 * i + (lane >> 5)];
    }
#pragma unroll
    for (int i = 0; i < 32; ++i) scr[(2 * i + (lane >> 5)) * 33 + (lane & 31)] = v[i];
    asm volatile("s_waitcnt lgkmcnt(0)" ::: "memory");
    const int c = lane & 7;
#pragma unroll
    for (int j = 0; j < 4; ++j) {
        const int n = (lane >> 3) + 8 * j; const LAS float* s = scr + (8 * c) * 33 + n;
        u32x4 ov; ov.x = cvt_pk_bf16(s[0 * 33], s[1 * 33]); ov.y = cvt_pk_bf16(s[2 * 33], s[3 * 33]); ov.z = cvt_pk_bf16(s[4 * 33], s[5 * 33]); ov.w = cvt_pk_bf16(s[6 * 33], s[7 * 33]);
        const int ng = n0 + n;
        const int row = mode ? ((ng >> 7) * 256 + (ng & 127) + off) : ng;
        *(u32x4*)(WT + (size_t)row * K + k0 + 8 * c) = ov;
    }
    asm volatile("s_waitcnt lgkmcnt(0)" ::: "memory");
}

__device__ __forceinline__ void grid_barrier(unsigned* bar, unsigned target) {
    asm volatile("s_waitcnt vmcnt(0) lgkmcnt(0)" ::: "memory");
    __syncthreads();
    if (threadIdx.x == 0) {
        __builtin_amdgcn_fence(__ATOMIC_RELEASE, "agent");
        asm volatile("s_waitcnt vmcnt(0)" ::: "memory");
        __hip_atomic_fetch_add(bar, 1u, __ATOMIC_RELAXED, __HIP_MEMORY_SCOPE_AGENT);
        while (__hip_atomic_load(bar, __ATOMIC_RELAXED, __HIP_MEMORY_SCOPE_AGENT) < target) { }
        __builtin_amdgcn_fence(__ATOMIC_ACQUIRE, "agent");
        asm volatile("s_waitcnt vmcnt(0)" ::: "memory");
    }
    __syncthreads();
}
#define GRID_SYNC() do { ++nbar; grid_barrier((unsigned*)(p.ws + WS_BAR), nbar * (unsigned)G); } while (0)
struct Params {
    const float* x; const float* norm1_g; const float* w_in;
    const float* pe_k; const float* w1_k; const float* w2_k; const float* pe_v; const float* w1_v; const float* w2_v;
    const float* gn_a; const float* gn_b; const float* w_out; const float* norm2_g; const float* w_gate; const float* w_up; const float* w_down; const float* final_g;
    float* out; unsigned char* ws;
};

__global__ void __launch_bounds__(512, 2) fwd_mega(Params p) {
    extern __shared__ __attribute__((aligned(16))) unsigned char lds_raw[];
    LAS unsigned char* lds = (LAS unsigned char*)lds_raw;
    cg::grid_group grid = cg::this_grid();
    const int tid = threadIdx.x, lane = tid & 63, wid = __builtin_amdgcn_readfirstlane(tid >> 6);
    const int G = gridDim.x, bx = blockIdx.x;
    unsigned nbar = 0;
#define ctl ((unsigned*)(p.ws + WS_CTL))
#define rsq2 ((float*)(p.ws + WS_RSQ2))
#define rsq3 ((float*)(p.ws + WS_RSQ3))
#define biasc ((float*)(p.ws + WS_BIASC))
#define biasp ((float*)(p.ws + WS_BIASP))
#define Wt_in ((bf16_t*)(p.ws + WS_WIN))
#define Wt_out ((bf16_t*)(p.ws + WS_WOUT))
#define Wt_gu ((bf16_t*)(p.ws + WS_WGU))
#define Wt_dn ((bf16_t*)(p.ws + WS_WDN))
#define Wt_c1 ((bf16_t*)(p.ws + WS_WC1))
#define W2t ((bf16_t*)(p.ws + WS_W2T))
#define craw ((bf16_t*)(p.ws + WS_CRAW))
#define hid ((bf16_t*)(p.ws + WS_HID))
#define kvc ((bf16_t*)(p.ws + WS_KVC))
#define lse ((float*)(p.ws + WS_LSE))
#define hn ((bf16_t*)(p.ws + WS_R1))
#define mixed ((bf16_t*)(p.ws + WS_R1))
#define proj ((bf16_t*)(p.ws + WS_PROJ))
#define act ((bf16_t*)(p.ws + WS_PROJ))
#define kva ((bf16_t*)(p.ws + WS_KVA))
#define kvs ((bf16_t*)(p.ws + WS_KVS))
#define ob ((bf16_t*)(p.ws + WS_OB))
#define hb ((bf16_t*)(p.ws + WS_OB))
#define oA ((bf16_t*)p.out)
    LAS int* slot = (LAS int*)(lds + LDS_SLOT);

    {
        const int gt = bx * 512 + tid;
        if (gt < T_) { rsq2[gt] = 0.f; rsq3[gt] = 0.f; }
        if (bx == 0 && tid < 16) ctl[tid] = 0u;
        if (bx == 0 && tid == 0) *(unsigned*)(p.ws + WS_BAR) = 0u;
        for (int job = bx; job < 64; job += G) {
            const int which = job >> 5, ks = job & 31;
            const float* pe = which ? p.pe_v : p.pe_k; const float* w1 = which ? p.w1_v : p.w1_k;
            const int n = tid & 255, kh = tid >> 8, kbeg = ks * 128 + kh * 64;
            float a = 0.f;
#pragma unroll 16
            for (int k = 0; k < 64; ++k) a += pe[kbeg + k] * w1[(size_t)(kbeg + k) * 256 + n];
            biasp[(size_t)(which * 64 + ks * 2 + kh) * 256 + n] = a;
        }
        LAS float* scr = (LAS float*)(lds + wid * 8704);
        const int gw = bx * 8 + wid, NGW = G * 8;
        constexpr int I_IN = 32 * 184, I_OUT = 32 * 64, I_G = 32 * 176, I_DN = 88 * 64, I_C1 = 64 * 8, I_W2 = 4 * 4;
        constexpr int NITEMS = I_IN + I_OUT + 2 * I_G + 2 * I_C1 + 2 * I_W2;
        for (int it = gw; it < NITEMS; it += NGW) {
            int r = it;
            if (r < I_IN) { transpose_item(p.w_in, DM, PIN, Wt_in, r, 184, scr, lane, nullptr, 0, 0); continue; } r -= I_IN;
            if (r < I_OUT) { transpose_item(p.w_out, DM, DM, Wt_out, r, 64, scr, lane, nullptr, 0, 0); continue; } r -= I_OUT;
            if (r < I_G) { transpose_item(p.w_gate, DM, FF, Wt_gu, r, 176, scr, lane, p.norm2_g, 1, 0); continue; } r -= I_G;
            if (r < I_G) { transpose_item(p.w_up, DM, FF, Wt_gu, r, 176, scr, lane, p.norm2_g, 1, 128); continue; } r -= I_G;
            if (r < I_C1) { transpose_item(p.w1_k, 4096, 256, Wt_c1, r, 8, scr, lane, nullptr, 0, 0); continue; } r -= I_C1;
            if (r < I_C1) { transpose_item(p.w1_v, 4096, 256, Wt_c1 + 256 * 4096, r, 8, scr, lane, nullptr, 0, 0); continue; } r -= I_C1;
            if (r < I_W2) { transpose_item(p.w2_k, 256, 128, W2t, r, 4, scr, lane, nullptr, 0, 0); continue; } r -= I_W2;
            transpose_item(p.w2_v, 256, 128, W2t + 128 * 256, r, 4, scr, lane, nullptr, 0, 0);
        }
        for (int row = gw; row < T_; row += NGW) {
            const f32x4* xr = (const f32x4*)(p.x + (size_t)row * DM) + lane;
            f32x4 v[8]; float ss = 0.f;
#pragma unroll
            for (int j = 0; j < 8; ++j) { v[j] = __builtin_nontemporal_load(xr + 64 * j); ss += (v[j][0] * v[j][0] + v[j][1] * v[j][1]) + (v[j][2] * v[j][2] + v[j][3] * v[j][3]); }
            const float r = rsqrtf(wave_sum(ss) * (1.f / DM) + EPS);
            u32x2* o8 = (u32x2*)(hn + (size_t)row * DM) + lane;
#pragma unroll
            for (int j = 0; j < 8; ++j) {
                const f32x4 gg = *((const f32x4*)p.norm1_g + lane + 64 * j);
                u32x2 w; w.x = cvt_pk_bf16(v[j][0] * r * gg[0], v[j][1] * r * gg[1]); w.y = cvt_pk_bf16(v[j][2] * r * gg[2], v[j][3] * r * gg[3]);
                o8[64 * j] = w;
            }
        }
    }
    asm volatile("s_waitcnt vmcnt(0) lgkmcnt(0)" ::: "memory");
    grid.sync();
    asm volatile("s_waitcnt vmcnt(0)" ::: "memory");

    if (bx < 2 && tid < 256) {
        float sacc = 0.f;
#pragma unroll 16
        for (int j = 0; j < 64; ++j) sacc += biasp[(size_t)(bx * 64 + j) * 256 + tid];
        biasc[bx * 256 + tid] = sacc;
    }
    {
        pg8::Gemm g{hn, Wt_in, T_, NP, DM, DM, DM}; pg8::StaticOrder S; S.init(T_, NP, G, bx);
        EpiProj E{proj, kva, kvs, craw};
        pg8::gemm_phase<EpiProj, pg8::StaticOrder>(lds, g, S, E);
        const int nunits = (T_ / 256) * (NP / 256), full = nunits / G, rem = nunits - full * G;
        if (rem > 0 && bx >= rem) {
            LAS float* scr = (LAS float*)(lds + wid * 8704);
            const int nidle = G - rem;
            for (int it = (bx - rem) * 8 + wid; it < 88 * 64; it += nidle * 8) transpose_item(p.w_down, FF, DM, Wt_dn, it, 64, scr, lane, nullptr, 0, 0);
        } else if (rem == 0) {
            LAS float* scr = (LAS float*)(lds + wid * 8704);
            for (int it = bx * 8 + wid; it < 88 * 64; it += G * 8) transpose_item(p.w_down, FF, DM, Wt_dn, it, 64, scr, lane, nullptr, 0, 0);
        }
    }
    GRID_SYNC();

    for (int job = bx; job < 16; job += G) {
        {
            const int which = job >> 3, bg = job & 7;
            bf16_t* hd = hid + (size_t)(which * 8 + bg) * 256 * 256;
            pg8::Gemm g{craw + (size_t)which * (8 * 4096 * 128), Wt_c1 + (size_t)which * 256 * 4096, 2048, 256, 4096, 2048, 4096};
            pg8::SingleOrder S{bg};
            EpiHid E{hd, biasc + which * 256};
            pg8::gemm_phase<EpiHid, pg8::SingleOrder>(lds, g, S, E);
        }
        __syncthreads();
    }
    for (;;) {
        __syncthreads();
        if (tid == 0) *slot = (int)atomicAdd(ctl + 0, 1u);
        __syncthreads();
        const int job = *slot;
        if (job >= 512 + 1536) break;
        if (job < 512) {
            const int j = job, qt = j & 15, hh = (j >> 4) & 7, b = j >> 7;
            const float slope2 = __builtin_amdgcn_exp2f(-(float)(hh + 1)) * LOG2E;
            const bf16_t* kwb = kvs + (size_t)2 * 4 * 2 * 4096 * 128 + (size_t)(b * 2 + (hh >> 2)) * 4096 * 128;
            band_job(lds, proj + (size_t)b * S_ * NQ + 1024 + hh * 128, NQ, kwb, kwb + (size_t)4 * 2 * 4096 * 128, 128,
                     qt * 256, 511, slope2, ob + (size_t)2 * T_ * 1024 + (size_t)b * S_ * 1024 + hh * 128, 1024, nullptr, 0);
        } else {
            const int j = job - 512, sub = j & 15, hh = (j >> 4) & 7, b = (j >> 7) & 3, cfg = j >> 9;
            const int dil = cfg == 0 ? 1 : (cfg == 1 ? 4 : 16);
            const int nqt = 16 / dil;
            const int r = sub / nqt, qt = sub % nqt;
            const float slope2 = __builtin_amdgcn_exp2f(-0.5f * (float)(2 * hh + 1)) * (float)dil * LOG2E;
            const bf16_t* kab = kva + ((size_t)(b * 8 + hh) * 4096 + r) * 128;
            band_job(lds, proj + (size_t)(b * S_ + r) * NQ + hh * 128, (long)dil * NQ, kab, kab + (size_t)4 * 8 * 4096 * 128, (long)dil * 128, qt * 256, 128, slope2,
                     oA + (size_t)cfg * T_ * 1024 + (size_t)(b * S_ + r) * 1024 + hh * 128, (long)dil * 1024,
                     lse + (size_t)cfg * T_ * 8 + (size_t)(b * S_ + r) * 8 + hh, (long)dil * 8);
        }
    }
    GRID_SYNC();

    for (int grp = bx; grp < 256; grp += G) {
        const int which = grp >> 7, bg = (grp >> 4) & 7, r0 = (grp & 15) * 16;
        const u32x4* wsrc = (const u32x4*)(W2t + (size_t)which * 128 * 256);
        const u32x4* hsrc = (const u32x4*)(hid + ((size_t)(which * 8 + bg) * 256 + r0) * 256);
        __syncthreads();
        for (int i = tid; i < 4096; i += 512) *(LAS u32x4*)(lds + i * 16) = wsrc[i];
        *(LAS u32x4*)(lds + 65536 + tid * 16) = hsrc[tid];
        __syncthreads();
        const int d = tid & 127, rq = tid >> 7;
        const LAS u32x4* wl = (const LAS u32x4*)(lds + d * 512);
        float acc2[4] = {0.f, 0.f, 0.f, 0.f};
        for (int jb = 0; jb < 32; ++jb) {
            const u32x4 wv = wl[(jb + d) & 31];
            const int jc = (jb + d) & 31;
#pragma unroll
            for (int r = 0; r < 4; ++r) {
                const u32x4 hv = *(const LAS u32x4*)(lds + 65536 + (rq * 4 + r) * 512 + jc * 16);
#pragma unroll
                for (int e = 0; e < 4; ++e) acc2[r] += bf_lo(wv[e]) * bf_lo(hv[e]) + bf_hi(wv[e]) * bf_hi(hv[e]);
            }
        }
        bf16_t* dstb = kvc + ((size_t)(which * 8 + bg) * 256 + r0) * 128;
#pragma unroll
        for (int r = 0; r < 4; ++r) {
            const int c = r0 + rq * 4 + r;
            const unsigned w16 = cvt_pk_bf16(c == 255 ? 0.f : acc2[r], 0.f);
            dstb[(size_t)(rq * 4 + r) * 128 + d] = (bf16_t)(w16 & 0xffffu);
        }
    }
    GRID_SYNC();

    for (;;) {
        __syncthreads();
        if (tid == 0) *slot = (int)atomicAdd(ctl + 1, 1u);
        __syncthreads();
        const int job = *slot;
        if (job >= 1024) break;
        const int chunk = 63 - (job >> 4), bg = job & 7, half = (job >> 3) & 1;
        nsa_job(lds, proj, kvs, kvc, kvc + (size_t)8 * 256 * 128, ob, ob + (size_t)T_ * 1024, bg >> 1, bg & 1, chunk, half);
    }
    GRID_SYNC();

    {
        const int gw = bx * 8 + wid, NGW = G * 8;
        for (int row = gw; row < T_; row += NGW) {
            u32x4 xa[3][2], xb[3][2];
#pragma unroll
            for (int i = 0; i < 3; ++i)
#pragma unroll
                for (int q = 0; q < 2; ++q) {
                    xa[i][q] = __builtin_nontemporal_load((const u32x4*)(oA + (size_t)(i * T_ + row) * 1024 + q * 512 + lane * 8));
                    xb[i][q] = __builtin_nontemporal_load((const u32x4*)(ob + (size_t)(i * T_ + row) * 1024 + q * 512 + lane * 8));
                }
            float o[16]; float ss = 0.f;
#pragma unroll
            for (int q = 0; q < 2; ++q) {
                const int h = q * 4 + (lane >> 4);
                const float l0 = lse[(size_t)row * 8 + h], l1 = lse[(size_t)(T_ + row) * 8 + h], l2 = lse[(size_t)(2 * T_ + row) * 8 + h];
                const float mx = fmaxf(l0, fmaxf(l1, l2));
                float w0 = __expf(l0 - mx), w1 = __expf(l1 - mx), w2 = __expf(l2 - mx);
                const float wi = 1.f / (w0 + w1 + w2); w0 *= wi; w1 *= wi; w2 *= wi;
#pragma unroll
                for (int e = 0; e < 4; ++e) {
                    o[q * 8 + 2 * e] = w0 * bf_lo(xa[0][q][e]) + w1 * bf_lo(xa[1][q][e]) + w2 * bf_lo(xa[2][q][e]);
                    o[q * 8 + 2 * e + 1] = w0 * bf_hi(xa[0][q][e]) + w1 * bf_hi(xa[1][q][e]) + w2 * bf_hi(xa[2][q][e]);
                }
            }
#pragma unroll
            for (int e = 0; e < 16; ++e) ss += o[e] * o[e];
            float r = rsqrtf(wave_sum(ss) * (1.f / 1024.f) + EPS);
#pragma unroll
            for (int q = 0; q < 2; ++q) {
                const f32x4 ga = *(const f32x4*)(p.gn_a + q * 512 + lane * 8), gb = *(const f32x4*)(p.gn_a + q * 512 + lane * 8 + 4);
                u32x4 w;
                w.x = cvt_pk_bf16(o[q * 8 + 0] * r * ga[0], o[q * 8 + 1] * r * ga[1]); w.y = cvt_pk_bf16(o[q * 8 + 2] * r * ga[2], o[q * 8 + 3] * r * ga[3]);
                w.z = cvt_pk_bf16(o[q * 8 + 4] * r * gb[0], o[q * 8 + 5] * r * gb[1]); w.w = cvt_pk_bf16(o[q * 8 + 6] * r * gb[2], o[q * 8 + 7] * r * gb[3]);
                *(u32x4*)(mixed + (size_t)row * DM + q * 512 + lane * 8) = w;
            }
            ss = 0.f;
#pragma unroll
            for (int q = 0; q < 2; ++q) {
                const int h = q * 4 + (lane >> 4);
                const bf16_t* gp = proj + (size_t)row * NQ + 2048 + h * 3;
                const float g0 = 1.f / (1.f + __expf(-bf1(gp[0]))), g1 = 1.f / (1.f + __expf(-bf1(gp[1]))), g2 = 1.f / (1.f + __expf(-bf1(gp[2])));
#pragma unroll
                for (int e = 0; e < 4; ++e) {
                    o[q * 8 + 2 * e] = g0 * bf_lo(xb[0][q][e]) + g1 * bf_lo(xb[1][q][e]) + g2 * bf_lo(xb[2][q][e]);
                    o[q * 8 + 2 * e + 1] = g0 * bf_hi(xb[0][q][e]) + g1 * bf_hi(xb[1][q][e]) + g2 * bf_hi(xb[2][q][e]);
                }
            }
#pragma unroll
            for (int e = 0; e < 16; ++e) ss += o[e] * o[e];
            r = rsqrtf(wave_sum(ss) * (1.f / 1024.f) + EPS);
#pragma unroll
            for (int q = 0; q < 2; ++q) {
                const f32x4 ga = *(const f32x4*)(p.gn_b + q * 512 + lane * 8), gb = *(const f32x4*)(p.gn_b + q * 512 + lane * 8 + 4);
                u32x4 w;
                w.x = cvt_pk_bf16(o[q * 8 + 0] * r * ga[0], o[q * 8 + 1] * r * ga[1]); w.y = cvt_pk_bf16(o[q * 8 + 2] * r * ga[2], o[q * 8 + 3] * r * ga[3]);
                w.z = cvt_pk_bf16(o[q * 8 + 4] * r * gb[0], o[q * 8 + 5] * r * gb[1]); w.w = cvt_pk_bf16(o[q * 8 + 6] * r * gb[2], o[q * 8 + 7] * r * gb[3]);
                *(u32x4*)(mixed + (size_t)row * DM + 1024 + q * 512 + lane * 8) = w;
            }
        }
    }
    GRID_SYNC();

    {
        pg8::Gemm g{mixed, Wt_out, T_, DM, DM, DM, DM}; pg8::StaticOrder S; S.init(T_, DM, G, bx);
        EpiWout E{p.x, hb, rsq2};
        pg8::gemm_phase<EpiWout, pg8::StaticOrder>(lds, g, S, E);
    }
    GRID_SYNC();

    {
        pg8::Gemm g{hb, Wt_gu, T_, 2 * FF, DM, DM, DM}; pg8::StaticOrder S; S.init(T_, 2 * FF, G, bx);
        EpiSwiglu E{act, rsq2};
        pg8::gemm_phase<EpiSwiglu, pg8::StaticOrder>(lds, g, S, E);
    }
    GRID_SYNC();

    {
        pg8::Gemm g{act, Wt_dn, T_, DM, FF, FF, FF}; pg8::StaticOrder S; S.init(T_, DM, G, bx);
        EpiDown E{hb, mixed, rsq3};
        pg8::gemm_phase<EpiDown, pg8::StaticOrder>(lds, g, S, E);
    }
    GRID_SYNC();

    {
        const int gw = bx * 8 + wid, NGW = G * 8;
        for (int row0 = gw; row0 < T_; row0 += 4 * NGW) {
            u32x4 yv[4][4];
#pragma unroll
            for (int i = 0; i < 4; ++i) {
                const int row = row0 + i * NGW;
                if (row < T_) {
#pragma unroll
                    for (int q = 0; q < 4; ++q) yv[i][q] = __builtin_nontemporal_load((const u32x4*)(mixed + (size_t)row * DM + q * 512 + lane * 8));
                }
            }
#pragma unroll
            for (int i = 0; i < 4; ++i) {
                const int row = row0 + i * NGW;
                if (row < T_) {
                    const float r = rsqrtf(rsq3[row] * (1.f / DM) + EPS);
#pragma unroll
                    for (int q = 0; q < 4; ++q) {
                        const f32x4 ga = *(const f32x4*)(p.final_g + q * 512 + lane * 8), gb = *(const f32x4*)(p.final_g + q * 512 + lane * 8 + 4);
                        const u32x4 w = yv[i][q];
                        f32x4 o0, o1;
                        o0[0] = bf_lo(w.x) * r * ga[0]; o0[1] = bf_hi(w.x) * r * ga[1]; o0[2] = bf_lo(w.y) * r * ga[2]; o0[3] = bf_hi(w.y) * r * ga[3];
                        o1[0] = bf_lo(w.z) * r * gb[0]; o1[1] = bf_hi(w.z) * r * gb[1]; o1[2] = bf_lo(w.w) * r * gb[2]; o1[3] = bf_hi(w.w) * r * gb[3];
                        float* dst = p.out + (size_t)row * DM + q * 512 + lane * 8;
                        __builtin_nontemporal_store(o0, (f32x4*)dst); __builtin_nontemporal_store(o1, (f32x4*)(dst + 4));
                    }
                }
            }
        }
    }
}

extern "C" void kernel_launch(void* const* d_in, const int* in_sizes, int n_in, void* d_out, int out_size, void* d_ws, size_t ws_size, hipStream_t stream) {
    static int grid_blocks = 0;
    if (grid_blocks == 0) {
        if (n_in != 17 || out_size != T_ * DM || ws_size < WS_END) { fprintf(stderr, "kernel_launch: unexpected shapes / workspace (n_in %d out %d ws %zu need %zu)\n", n_in, out_size, ws_size, (size_t)WS_END); grid_blocks = -1; return; }
        int dev = 0, cus = 0, per_cu = 0;
        hipGetDevice(&dev);
        hipDeviceGetAttribute(&cus, hipDeviceAttributeMultiprocessorCount, dev);
        if (hipFuncSetAttribute((const void*)fwd_mega, hipFuncAttributeMaxDynamicSharedMemorySize, LDS_BYTES) != hipSuccess) { fprintf(stderr, "kernel_launch: hipFuncSetAttribute failed\n"); grid_blocks = -1; return; }
        if (hipOccupancyMaxActiveBlocksPerMultiprocessor(&per_cu, (const void*)fwd_mega, 512, LDS_BYTES) != hipSuccess || per_cu < 1) { fprintf(stderr, "kernel_launch: occupancy query failed (%d)\n", per_cu); per_cu = 1; (void)hipGetLastError(); }
        if (per_cu > 1) per_cu = 1;
        grid_blocks = cus * per_cu;
    }
    if (grid_blocks < 0) return;
    Params p{};
    p.x = (const float*)d_in[0]; p.norm1_g = (const float*)d_in[1]; p.w_in = (const float*)d_in[2];
    p.pe_k = (const float*)d_in[3]; p.w1_k = (const float*)d_in[4]; p.w2_k = (const float*)d_in[5];
    p.pe_v = (const float*)d_in[6]; p.w1_v = (const float*)d_in[7]; p.w2_v = (const float*)d_in[8];
    p.gn_a = (const float*)d_in[9]; p.gn_b = (const float*)d_in[10]; p.w_out = (const float*)d_in[11]; p.norm2_g = (const float*)d_in[12];
    p.w_gate = (const float*)d_in[13]; p.w_up = (const float*)d_in[14]; p.w_down = (const float*)d_in[15]; p.final_g = (const float*)d_in[16];
    p.out = (float*)d_out; p.ws = (unsigned char*)d_ws;
    void* args[] = {&p};
    hipError_t e = hipLaunchCooperativeKernel((const void*)fwd_mega, dim3(grid_blocks), dim3(512), args, LDS_BYTES, stream);
    if (e != hipSuccess) fprintf(stderr, "cooperative launch failed: %s (grid %d)\n", hipGetErrorString(e), grid_blocks);
}
```
